# Optimizing an MI355X kernel written in HIP

```python
import math
import jax
import jax.numpy as jnp
from jax import lax
import numpy as np

D_MODEL = 1024
BATCH = 2
SEQ = 16384
DEPTH = 1
DEC_BATCH = 16
DEC_SEQ = 32
PAST_LEN = 1024

CHUNK = 64
MIX = D_MODEL
DN_WIDTH = MIX // 2
S5_WIDTH = MIX - DN_WIDTH
DN_HEADS = 4
DN_DK = DN_WIDTH // DN_HEADS
DN_DV = DN_WIDTH // DN_HEADS
CONV_K = 4
CONV_CH = 2 * DN_HEADS * DN_DK + DN_HEADS * DN_DV
S5_GROUP = 16
S5_GROUPS = S5_WIDTH // S5_GROUP
S5_STATE = 64
IN_COLS = CONV_CH + 2 * DN_HEADS + DN_WIDTH + 2 * S5_WIDTH
EPS = 1e-6
L2_EPS = 1e-6

kernel_name = "hymba_gdn_s5_stream_step"


def rms_norm(x, w):
    xf = x.astype(jnp.float32)
    return xf * lax.rsqrt(jnp.mean(xf * xf, axis=-1, keepdims=True) + EPS) * w.astype(jnp.float32)


def l2_normalize(x):
    return x * lax.rsqrt(jnp.sum(x * x, axis=-1, keepdims=True) + L2_EPS)


def causal_short_conv(u, buf, w):
    T = u.shape[1]
    up = jnp.concatenate([buf, u], axis=1)
    out = up[:, 0:T] * w[0]
    for j in range(1, CONV_K):
        out = out + up[:, j:j + T] * w[j]
    return jax.nn.silu(out), up[:, T:]


def gated_delta_rule(q, k, v, g, beta, s0):
    bsz, T, H, _ = q.shape
    blk = min(CHUNK, T)
    nb = T // blk

    def to_blocks(t):
        return t.reshape(bsz, nb, blk, H, -1).transpose(1, 0, 3, 2, 4)

    q, k, v = to_blocks(q), to_blocks(k), to_blocks(v)
    g = g.reshape(bsz, nb, blk, H).transpose(1, 0, 3, 2)
    beta = beta.reshape(bsz, nb, blk, H).transpose(1, 0, 3, 2)
    gc = jnp.cumsum(g, axis=-1)
    incl = jnp.tril(jnp.ones((blk, blk), dtype=bool))
    strict = jnp.tril(jnp.ones((blk, blk), dtype=bool), k=-1)
    diff = gc[..., :, None] - gc[..., None, :]
    decay = jnp.where(incl, jnp.exp(jnp.where(incl, diff, 0.0)), 0.0)
    kb = k * beta[..., None]
    eye = jnp.eye(blk, dtype=jnp.float32)
    lower = jnp.where(strict, jnp.einsum('nbhid,nbhjd->nbhij', kb, k) * decay, 0.0) + eye
    u = lax.linalg.triangular_solve(lower, v * beta[..., None], left_side=True, lower=True,
                                    unit_diagonal=True)
    w = lax.linalg.triangular_solve(lower, kb * jnp.exp(gc)[..., None], left_side=True, lower=True,
                                    unit_diagonal=True)
    attn = jnp.where(incl, jnp.einsum('nbhid,nbhjd->nbhij', q, k) * decay, 0.0)

    def step(S, xs):
        q_b, k_b, u_b, w_b, a_b, gc_b = xs
        v_new = u_b - jnp.einsum('bhcd,bhde->bhce', w_b, S)
        o = (jnp.einsum('bhcd,bhde->bhce', q_b * jnp.exp(gc_b)[..., None], S)
             + jnp.einsum('bhij,bhje->bhie', a_b, v_new))
        g_last = gc_b[..., -1]
        k_dec = k_b * jnp.exp(g_last[..., None] - gc_b)[..., None]
        S = S * jnp.exp(g_last)[..., None, None] + jnp.einsum('bhcd,bhce->bhde', k_dec, v_new)
        return S, o

    s_final, o = lax.scan(step, s0, (q, k, u, w, attn, gc))
    o = o.transpose(1, 0, 3, 2, 4).reshape(bsz, T, H, -1)
    return o, s_final


def s5_ssm(u, x0_re, x0_im, A_re, A_im, log_dt, B_re, B_im, C_re, C_im, D):
    bsz, T, _ = u.shape
    ug = u.reshape(bsz, T, S5_GROUPS, S5_GROUP)
    lam_re = jnp.minimum(A_re.astype(jnp.float32), -1e-4)
    lam_im = A_im.astype(jnp.float32)
    dt = jnp.exp(log_dt.astype(jnp.float32))[:, None]
    ldt_re, ldt_im = lam_re * dt, lam_im * dt
    mag = jnp.exp(ldt_re)
    lb_re, lb_im = mag * jnp.cos(ldt_im), mag * jnp.sin(ldt_im)
    den = lam_re * lam_re + lam_im * lam_im
    f_re = ((lb_re - 1.0) * lam_re + lb_im * lam_im) / den
    f_im = (lb_im * lam_re - (lb_re - 1.0) * lam_im) / den
    B_re = B_re.astype(jnp.float32)
    B_im = B_im.astype(jnp.float32)
    bb_re = f_re[..., None] * B_re - f_im[..., None] * B_im
    bb_im = f_re[..., None] * B_im + f_im[..., None] * B_re
    bu_re = jnp.einsum('btgc,gnc->btgn', ug, bb_re)
    bu_im = jnp.einsum('btgc,gnc->btgn', ug, bb_im)
    a_re = jnp.broadcast_to(lb_re, (1, T, S5_GROUPS, S5_STATE))
    a_im = jnp.broadcast_to(lb_im, (1, T, S5_GROUPS, S5_STATE))

    def combine(e1, e2):
        a1r, a1i, b1r, b1i = e1
        a2r, a2i, b2r, b2i = e2
        return (a1r * a2r - a1i * a2i,
                a1r * a2i + a1i * a2r,
                a2r * b1r - a2i * b1i + b2r,
                a2r * b1i + a2i * b1r + b2i)

    _, _, xr, xi = lax.associative_scan(combine, (a_re, a_im, bu_re, bu_im), axis=1)
    kpow = jnp.arange(1, T + 1, dtype=jnp.float32)[:, None, None]
    p_mag = jnp.exp(ldt_re * kpow)
    p_re, p_im = p_mag * jnp.cos(ldt_im * kpow), p_mag * jnp.sin(ldt_im * kpow)
    x0_re = x0_re[:, None]
    x0_im = x0_im[:, None]
    xr = xr + p_re * x0_re - p_im * x0_im
    xi = xi + p_re * x0_im + p_im * x0_re
    y = (jnp.einsum('btgn,gcn->btgc', xr, C_re.astype(jnp.float32))
         - jnp.einsum('btgn,gcn->btgc', xi, C_im.astype(jnp.float32))
         + D.astype(jnp.float32).reshape(S5_GROUPS, S5_GROUP) * ug)
    return y.reshape(bsz, T, S5_WIDTH), xr[:, -1], xi[:, -1]


def hybrid_layer(x, conv_buf, s_dn, s5_re, s5_im, norm_w, w_in, conv_w, dn_A_log, dn_dt_bias,
                 dn_norm_w, s5_A_re, s5_A_im, s5_log_dt, s5_B_re, s5_B_im, s5_C_re, s5_C_im, s5_D,
                 glu_w, glu_b, w_out):
    bsz, T, _ = x.shape
    h = rms_norm(x, norm_w).astype(x.dtype)
    p = jnp.einsum('btd,de->bte', h, w_in).astype(jnp.float32)
    o0 = CONV_CH
    o1 = o0 + DN_HEADS
    o2 = o1 + DN_HEADS
    o3 = o2 + DN_WIDTH
    o4 = o3 + S5_WIDTH
    qkv_raw, a_logit, b_logit = p[..., :o0], p[..., o0:o1], p[..., o1:o2]
    z_dn, u_s5, z_s5 = p[..., o2:o3], p[..., o3:o4], p[..., o4:]

    qkv, new_buf = causal_short_conv(qkv_raw, conv_buf.astype(jnp.float32), conv_w.astype(jnp.float32))
    nqk = DN_HEADS * DN_DK
    q = qkv[..., :nqk].reshape(bsz, T, DN_HEADS, DN_DK)
    k = qkv[..., nqk:2 * nqk].reshape(bsz, T, DN_HEADS, DN_DK)
    v = qkv[..., 2 * nqk:].reshape(bsz, T, DN_HEADS, DN_DV)
    q = l2_normalize(q) * (DN_DK ** -0.5)
    k = l2_normalize(k)
    beta = jax.nn.sigmoid(b_logit)
    g = -jnp.exp(dn_A_log.astype(jnp.float32)) * jax.nn.softplus(a_logit + dn_dt_bias.astype(jnp.float32))
    o_dn, s_dn_new = gated_delta_rule(q, k, v, g, beta, s_dn.astype(jnp.float32))
    o_dn = rms_norm(o_dn, dn_norm_w) * jax.nn.silu(z_dn.reshape(bsz, T, DN_HEADS, DN_DV))

    y_s5, re_new, im_new = s5_ssm(u_s5, s5_re.astype(jnp.float32), s5_im.astype(jnp.float32),
                                  s5_A_re, s5_A_im, s5_log_dt, s5_B_re, s5_B_im, s5_C_re, s5_C_im, s5_D)
    gy = jax.nn.gelu(y_s5)
    o_s5 = gy * jax.nn.sigmoid(gy @ glu_w.astype(jnp.float32) + glu_b.astype(jnp.float32)) * jax.nn.silu(z_s5)

    mixed = jnp.concatenate([o_dn.reshape(bsz, T, DN_WIDTH), o_s5], axis=-1).astype(x.dtype)
    x_new = x + jnp.einsum('bte,ed->btd', mixed, w_out)
    return x_new, new_buf, s_dn_new, re_new, im_new


def setup_inputs(seed: int = 0) -> dict:
    key = jax.random.key(seed)
    ks = jax.random.split(key, 24)
    f32 = jnp.float32
    nrm = lambda k, s, sc: jax.random.normal(k, s, f32) * sc
    x_prompt = nrm(ks[0], (BATCH, SEQ, D_MODEL), 1.0)
    x_sample = nrm(ks[1], (DEC_BATCH, DEC_SEQ, D_MODEL), 1.0)
    cache_conv = nrm(ks[2], (DEPTH, DEC_BATCH, CONV_K - 1, CONV_CH), 1.0)
    state_dn = nrm(ks[3], (DEPTH, DEC_BATCH, DN_HEADS, DN_DK, DN_DV), 0.1)
    state_s5_re = nrm(ks[4], (DEPTH, DEC_BATCH, S5_GROUPS, S5_STATE), 0.1)
    state_s5_im = nrm(ks[5], (DEPTH, DEC_BATCH, S5_GROUPS, S5_STATE), 0.1)
    norm_w = 1.0 + nrm(ks[6], (DEPTH, D_MODEL), 0.02)
    w_in = nrm(ks[7], (DEPTH, D_MODEL, IN_COLS), D_MODEL ** -0.5)
    conv_w = nrm(ks[8], (DEPTH, CONV_K, CONV_CH), CONV_K ** -0.5)
    dn_A_log = jnp.log(jax.random.uniform(ks[9], (DEPTH, DN_HEADS), f32, 1.0, 16.0))
    dt0 = jnp.exp(jax.random.uniform(ks[10], (DEPTH, DN_HEADS), f32, math.log(1e-3), math.log(1e-1)))
    dn_dt_bias = dt0 + jnp.log(-jnp.expm1(-dt0))
    dn_norm_w = 1.0 + nrm(ks[11], (DEPTH, DN_DV), 0.02)
    s5_A_re = -0.5 + nrm(ks[12], (DEPTH, S5_GROUPS, S5_STATE), 0.01)
    s5_A_im = (math.pi * jnp.arange(S5_STATE, dtype=f32))[None, None, :] + nrm(ks[13], (DEPTH, S5_GROUPS, S5_STATE), 0.01)
    s5_log_dt = jax.random.uniform(ks[14], (DEPTH, S5_GROUPS), f32, math.log(1e-3), math.log(1e-1))
    s5_B_re = nrm(ks[15], (DEPTH, S5_GROUPS, S5_STATE, S5_GROUP), (2 * S5_GROUP) ** -0.5)
    s5_B_im = nrm(ks[16], (DEPTH, S5_GROUPS, S5_STATE, S5_GROUP), (2 * S5_GROUP) ** -0.5)
    s5_C_re = nrm(ks[17], (DEPTH, S5_GROUPS, S5_GROUP, S5_STATE), (2 * S5_STATE) ** -0.5)
    s5_C_im = nrm(ks[18], (DEPTH, S5_GROUPS, S5_GROUP, S5_STATE), (2 * S5_STATE) ** -0.5)
    s5_D = nrm(ks[19], (DEPTH, S5_WIDTH), 1.0)
    glu_w = nrm(ks[20], (DEPTH, S5_WIDTH, S5_WIDTH), S5_WIDTH ** -0.5)
    glu_b = nrm(ks[21], (DEPTH, S5_WIDTH), 0.01)
    w_out = nrm(ks[22], (DEPTH, MIX, D_MODEL), MIX ** -0.5)
    final_norm_w = 1.0 + nrm(ks[23], (D_MODEL,), 0.02)
    return {"x_prompt": x_prompt, "x_sample": x_sample, "cache_conv": cache_conv, "state_dn": state_dn,
            "state_s5_re": state_s5_re, "state_s5_im": state_s5_im, "norm_w": norm_w, "w_in": w_in,
            "conv_w": conv_w, "dn_A_log": dn_A_log, "dn_dt_bias": dn_dt_bias, "dn_norm_w": dn_norm_w,
            "s5_A_re": s5_A_re, "s5_A_im": s5_A_im, "s5_log_dt": s5_log_dt, "s5_B_re": s5_B_re,
            "s5_B_im": s5_B_im, "s5_C_re": s5_C_re, "s5_C_im": s5_C_im, "s5_D": s5_D, "glu_w": glu_w,
            "glu_b": glu_b, "w_out": w_out, "final_norm_w": final_norm_w}


def reference(x_prompt, x_sample, cache_conv, state_dn, state_s5_re, state_s5_im, norm_w, w_in, conv_w,
              dn_A_log, dn_dt_bias, dn_norm_w, s5_A_re, s5_A_im, s5_log_dt, s5_B_re, s5_B_im, s5_C_re,
              s5_C_im, s5_D, glu_w, glu_b, w_out, final_norm_w):
    bp = x_prompt.shape[0]
    yp, ys = x_prompt, x_sample
    conv_p, dn_p, re_p, im_p = [], [], [], []
    conv_s, dn_s, re_s, im_s = [], [], [], []
    for l in range(DEPTH):
        lw = (norm_w[l], w_in[l], conv_w[l], dn_A_log[l], dn_dt_bias[l], dn_norm_w[l], s5_A_re[l],
              s5_A_im[l], s5_log_dt[l], s5_B_re[l], s5_B_im[l], s5_C_re[l], s5_C_im[l], s5_D[l],
              glu_w[l], glu_b[l], w_out[l])
        yp, c1, d1, r1, i1 = hybrid_layer(
            yp, jnp.zeros((bp, CONV_K - 1, CONV_CH), jnp.float32),
            jnp.zeros((bp, DN_HEADS, DN_DK, DN_DV), jnp.float32),
            jnp.zeros((bp, S5_GROUPS, S5_STATE), jnp.float32),
            jnp.zeros((bp, S5_GROUPS, S5_STATE), jnp.float32), *lw)
        ys, c2, d2, r2, i2 = hybrid_layer(ys, cache_conv[l], state_dn[l], state_s5_re[l], state_s5_im[l], *lw)
        conv_p.append(c1); dn_p.append(d1); re_p.append(r1); im_p.append(i1)
        conv_s.append(c2); dn_s.append(d2); re_s.append(r2); im_s.append(i2)
    y_prompt = rms_norm(yp, final_norm_w).astype(x_prompt.dtype)
    y_sample = rms_norm(ys, final_norm_w).astype(x_sample.dtype)
    new_conv_prompt = jnp.stack(conv_p).astype(cache_conv.dtype)
    new_dn_prompt = jnp.stack(dn_p).astype(state_dn.dtype)
    new_s5_re_prompt = jnp.stack(re_p).astype(state_s5_re.dtype)
    new_s5_im_prompt = jnp.stack(im_p).astype(state_s5_im.dtype)
    new_conv_sample = jnp.stack(conv_s).astype(cache_conv.dtype)
    new_dn_sample = jnp.stack(dn_s).astype(state_dn.dtype)
    new_s5_re_sample = jnp.stack(re_s).astype(state_s5_re.dtype)
    new_s5_im_sample = jnp.stack(im_s).astype(state_s5_im.dtype)
    return (y_prompt, y_sample, new_conv_prompt, new_dn_prompt, new_s5_re_prompt, new_s5_im_prompt,
            new_conv_sample, new_dn_sample, new_s5_re_sample, new_s5_im_sample)
```

```cpp
#include <hip/hip_runtime.h>
#include <hip/hip_cooperative_groups.h>
#include <cstdio>
namespace cg = cooperative_groups;

typedef unsigned short u16;
typedef short bf16x8 __attribute__((ext_vector_type(8)));
typedef float f32x16 __attribute__((ext_vector_type(16)));
typedef float f32x8 __attribute__((ext_vector_type(8)));
typedef float f32x4 __attribute__((ext_vector_type(4)));
typedef float f32x2 __attribute__((ext_vector_type(2)));
typedef unsigned u32x4 __attribute__((ext_vector_type(4)));
typedef unsigned u32x2 __attribute__((ext_vector_type(2)));
#define DI __device__ __forceinline__
#define MFMA32(a, b, c) __builtin_amdgcn_mfma_f32_32x32x16_bf16(__builtin_bit_cast(bf16x8, (a)), __builtin_bit_cast(bf16x8, (b)), (c), 0, 0, 0)
#define MFMA16(a, b, c) __builtin_amdgcn_mfma_f32_16x16x32_bf16(__builtin_bit_cast(bf16x8, (a)), __builtin_bit_cast(bf16x8, (b)), (c), 0, 0, 0)

constexpr int T_ALL = 33280, NP = 32768, NSLOT = 528, NITEM = NSLOT * 4;
constexpr int LDS_BYTES = 75776;

struct Params {
    const float *x_prompt, *x_sample, *cache_conv, *state_dn, *s5re0, *s5im0, *norm_w, *w_in, *conv_w, *A_log, *dt_bias,
        *dn_norm_w, *A_re, *A_im, *log_dt, *B_re, *B_im, *C_re, *C_im, *Dp, *glu_w, *glu_b, *w_out, *fnorm_w;
    float* out;
    u16 *Wb1, *Wb2, *Wb3, *bbm, *Cm, *xb, *p, *chP, *chQ, *chQeff, *chOl, *chS;
    float *lbt, *lb64, *gbeta, *E, *carry;
    unsigned* bar;
};

constexpr size_t O_Y = 0;
constexpr size_t O_CONV_P = (size_t)T_ALL * 1024;
constexpr size_t O_DN_P = O_CONV_P + 2 * 3 * 1536;
constexpr size_t O_RE_P = O_DN_P + 2 * 4 * 128 * 128;
constexpr size_t O_IM_P = O_RE_P + 2 * 32 * 64;
constexpr size_t O_CONV_S = O_IM_P + 2 * 32 * 64;
constexpr size_t O_DN_S = O_CONV_S + 16 * 3 * 1536;
constexpr size_t O_RE_S = O_DN_S + 16 * 4 * 128 * 128;
constexpr size_t O_IM_S = O_RE_S + 16 * 32 * 64;

DI int opaque_tid() { int t = threadIdx.x; asm volatile("" : "+v"(t)); return t; }
typedef __bf16 bf16x2_t __attribute__((ext_vector_type(2)));
DI u16 f2bf(float x) { return __builtin_bit_cast(u16, (__bf16)x); }
DI unsigned pk2(float a, float b) { bf16x2_t v; v[0] = (__bf16)a; v[1] = (__bf16)b; return __builtin_bit_cast(unsigned, v); }
DI float bf2f(u16 b) { return __uint_as_float(((unsigned)b) << 16); }
DI float bflo(unsigned v) { return __uint_as_float(v << 16); }
DI float bfhi(unsigned v) { return __uint_as_float(v & 0xffff0000u); }
DI int crow(int r, int hh) { return (r & 3) + 8 * (r >> 2) + 4 * hh; }
DI float silu_f(float x) { return x * __builtin_amdgcn_rcpf(1.f + __expf(-x)); }
DI float sigmoid_f(float x) { return 1.f / (1.f + __expf(-x)); }
DI float gelu_f(float x) { const float z = 0.7978845608028654f * (x + 0.044715f * x * x * x); return x / (1.f + __expf(-2.f * z)); }
DI void slot_info(int slot, int& row0, int& L) { if (slot < 512) { row0 = slot * 64; L = 64; } else { row0 = NP + (slot - 512) * 32; L = 32; } }
DI f32x16 zero16() { f32x16 z; for (int i = 0; i < 16; ++i) z[i] = 0.f; return z; }

template <int BM, class Epi>
DI void gemm_tile(const u16* __restrict__ A, int lda, const u16* __restrict__ Bt, int ldb, int K, char* smem, Epi& epi) {
    constexpr int LDT = 72;
    u16* As = (u16*)smem;
    u16* Bs = As + 2 * BM * LDT;
    constexpr int ACH = BM * 8 / 256, BCH = 4, NT = (BM == 128) ? 2 : 1;
    const int tid = opaque_tid(), lane = tid & 63, w = tid >> 6, l31 = lane & 31, hh = lane >> 5;
    const int wrow = (BM == 128) ? (w >> 1) * 64 : 0, wcol = (BM == 128) ? (w & 1) * 64 : w * 32;
    u32x4 ra[2][ACH], rb[2][BCH];
    f32x16 acc[2][NT];
#pragma unroll
    for (int m = 0; m < 2; ++m)
#pragma unroll
        for (int n = 0; n < NT; ++n) acc[m][n] = zero16();
    const int nk = K >> 6;
#define GLOAD(st, kt) do { \
        _Pragma("unroll") for (int i = 0; i < ACH; ++i) { const int id = tid + i * 256, r = id >> 3, c = id & 7; ra[st][i] = *(const u32x4*)(A + (size_t)r * lda + (kt) * 64 + c * 8); } \
        _Pragma("unroll") for (int i = 0; i < BCH; ++i) { const int id = tid + i * 256, r = id >> 3, c = id & 7; rb[st][i] = *(const u32x4*)(Bt + (size_t)r * ldb + (kt) * 64 + c * 8); } } while (0)
#define SSTORE(st, buf) do { \
        _Pragma("unroll") for (int i = 0; i < ACH; ++i) { const int id = tid + i * 256, r = id >> 3, c = id & 7; *(u32x4*)(As + (buf) * BM * LDT + r * LDT + c * 8) = ra[st][i]; } \
        _Pragma("unroll") for (int i = 0; i < BCH; ++i) { const int id = tid + i * 256, r = id >> 3, c = id & 7; *(u32x4*)(Bs + (buf) * 128 * LDT + r * LDT + c * 8) = rb[st][i]; } } while (0)
#define COMPUTE(buf) do { \
        const u16* as = As + (buf) * BM * LDT; const u16* bs = Bs + (buf) * 128 * LDT; \
        _Pragma("unroll") for (int s = 0; s < 4; ++s) { \
            u32x4 a[2], b[NT]; \
            _Pragma("unroll") for (int m = 0; m < 2; ++m) a[m] = *(const u32x4*)(as + (wrow + 32 * m + l31) * LDT + 16 * s + 8 * hh); \
            _Pragma("unroll") for (int n = 0; n < NT; ++n) b[n] = *(const u32x4*)(bs + (wcol + 32 * n + l31) * LDT + 16 * s + 8 * hh); \
            _Pragma("unroll") for (int m = 0; m < 2; ++m) _Pragma("unroll") for (int n = 0; n < NT; ++n) acc[m][n] = MFMA32(a[m], b[n], acc[m][n]); } } while (0)
#define LBAR() asm volatile("s_waitcnt lgkmcnt(0)\n\ts_barrier" ::: "memory")
    GLOAD(0, 0); SSTORE(0, 0);
    GLOAD(1, 1); GLOAD(0, 2);
    LBAR();
    for (int kt = 0; kt < nk; kt += 2) {
        COMPUTE(0);
        SSTORE(1, 1);
        if (kt + 3 < nk) GLOAD(1, kt + 3);
        LBAR();
        COMPUTE(1);
        if (kt + 2 < nk) { SSTORE(0, 0); if (kt + 4 < nk) GLOAD(0, kt + 4); }
        LBAR();
    }
#undef GLOAD
#undef SSTORE
#undef COMPUTE
#undef LBAR
#pragma unroll
    for (int m = 0; m < 2; ++m)
#pragma unroll
        for (int n = 0; n < NT; ++n) epi(wrow + 32 * m, wcol + 32 * n + l31, hh, acc[m][n]);
}


template <class Epi>
DI void gemm_tile_wide(const u16* __restrict__ A, int lda, const u16* __restrict__ Bt, int ldb, int K, char* smem, Epi& epi) {
    constexpr int LDT = 72;
    u16* As = (u16*)smem;
    u16* Bs = As + 128 * LDT;
    const int tid = opaque_tid(), lane = tid & 63, w = tid >> 6, l31 = lane & 31, hh = lane >> 5;
    const int wrow = (w >> 1) * 64, wcol = (w & 1) * 128;
    u32x4 ra[4], rb[8];
    f32x16 acc[2][4];
#pragma unroll
    for (int m = 0; m < 2; ++m)
#pragma unroll
        for (int n = 0; n < 4; ++n) acc[m][n] = zero16();
    const int nk = K >> 6;
#define WGLOAD(kt) do { \
        _Pragma("unroll") for (int i = 0; i < 4; ++i) { const int id = tid + i * 256, r = id >> 3, c = id & 7; ra[i] = *(const u32x4*)(A + (size_t)r * lda + (kt) * 64 + c * 8); } \
        _Pragma("unroll") for (int i = 0; i < 8; ++i) { const int id = tid + i * 256, r = id >> 3, c = id & 7; rb[i] = *(const u32x4*)(Bt + (size_t)r * ldb + (kt) * 64 + c * 8); } } while (0)
#define WSSTORE() do { \
        _Pragma("unroll") for (int i = 0; i < 4; ++i) { const int id = tid + i * 256, r = id >> 3, c = id & 7; *(u32x4*)(As + r * LDT + c * 8) = ra[i]; } \
        _Pragma("unroll") for (int i = 0; i < 8; ++i) { const int id = tid + i * 256, r = id >> 3, c = id & 7; *(u32x4*)(Bs + r * LDT + c * 8) = rb[i]; } } while (0)
#define WLBAR() asm volatile("s_waitcnt lgkmcnt(0)\n\ts_barrier" ::: "memory")
    WGLOAD(0); WSSTORE(); WLBAR();
    for (int kt = 0; kt < nk; ++kt) {
        if (kt + 1 < nk) WGLOAD(kt + 1);
#pragma unroll
        for (int s = 0; s < 4; ++s) {
            u32x4 a[2], b[4];
#pragma unroll
            for (int m = 0; m < 2; ++m) a[m] = *(const u32x4*)(As + (wrow + 32 * m + l31) * LDT + 16 * s + 8 * hh);
#pragma unroll
            for (int n = 0; n < 4; ++n) b[n] = *(const u32x4*)(Bs + (wcol + 32 * n + l31) * LDT + 16 * s + 8 * hh);
#pragma unroll
            for (int m = 0; m < 2; ++m)
#pragma unroll
                for (int n = 0; n < 4; ++n) acc[m][n] = MFMA32(a[m], b[n], acc[m][n]);
        }
        WLBAR();
        if (kt + 1 < nk) WSSTORE();
        WLBAR();
    }
#undef WGLOAD
#undef WSSTORE
#undef WLBAR
#pragma unroll
    for (int m = 0; m < 2; ++m)
#pragma unroll
        for (int n = 0; n < 4; ++n) epi(wrow + 32 * m, wcol + 32 * n + l31, hh, acc[m][n]);
}

DI void ph0_transpose(const Params& P, int item, float* tile) {
    const int tid = opaque_tid();
    const float* src; const float* scale = nullptr; u16* dst; int lds, ldd, n0, k0, csrc;
    if (item < 768) { const int nt = item >> 4, kt = item & 15; src = P.w_in; lds = 3080; n0 = nt * 64; csrc = n0 < 1536 ? n0 : n0 + 8; k0 = kt * 64; scale = P.norm_w; dst = P.Wb1; ldd = 1024; }
    else if (item < 1024) { const int j = item - 768, nt = j >> 4, kt = j & 15; src = P.w_out; lds = 1024; n0 = nt * 64; csrc = n0; k0 = kt * 64; dst = P.Wb2; ldd = 1024; }
    else { const int j = item - 1024, nt = j >> 3, kt = j & 7; src = P.glu_w; lds = 512; n0 = nt * 64; csrc = n0; k0 = kt * 64; dst = P.Wb3; ldd = 512; }
#pragma unroll 4
    for (int r = 0; r < 16; ++r) { const int kk = r * 4 + (tid >> 6), nn = tid & 63; float v = src[(size_t)(k0 + kk) * lds + csrc + nn]; if (scale) v *= scale[k0 + kk]; tile[kk * 65 + nn] = v; }
    __syncthreads();
#pragma unroll 4
    for (int r = 0; r < 16; ++r) { const int nn = r * 4 + (tid >> 6), kk = tid & 63; dst[(size_t)(n0 + nn) * ldd + k0 + kk] = f2bf(tile[kk * 65 + nn]); }
    __syncthreads();
}

DI void ph0_s5const(const Params& P, int idx) {
    const int g = idx >> 6, n = idx & 63;
    const float lam_re = fminf(P.A_re[idx], -1e-4f), lam_im = P.A_im[idx], dt = expf(P.log_dt[g]);
    const float ldr = lam_re * dt, ldi = lam_im * dt, mag = expf(ldr);
    const float lbr = mag * cosf(ldi), lbi = mag * sinf(ldi);
    const float den = lam_re * lam_re + lam_im * lam_im;
    const float f_re = ((lbr - 1.f) * lam_re + lbi * lam_im) / den, f_im = (lbi * lam_re - (lbr - 1.f) * lam_im) / den;
    P.lbt[idx * 2] = lbr; P.lbt[idx * 2 + 1] = lbi;
    float pr = lbr, pi = lbi;
#pragma unroll
    for (int i = 0; i < 6; ++i) { const float nr = pr * pr - pi * pi, ni = 2.f * pr * pi; pr = nr; pi = ni; }
    P.lb64[idx * 2] = pr; P.lb64[idx * 2 + 1] = pi;
#pragma unroll
    for (int c = 0; c < 16; ++c) {
        const float Br = P.B_re[idx * 16 + c], Bi = P.B_im[idx * 16 + c];
        P.bbm[(g * 128 + n) * 16 + c] = f2bf(f_re * Br - f_im * Bi);
        P.bbm[(g * 128 + 64 + n) * 16 + c] = f2bf(f_re * Bi + f_im * Br);
        P.Cm[(g * 16 + c) * 128 + 2 * n] = f2bf(P.C_re[(g * 16 + c) * 64 + n]);
        P.Cm[(g * 16 + c) * 128 + 2 * n + 1] = f2bf(-P.C_im[(g * 16 + c) * 64 + n]);
    }
}

DI float wave_sum(float v) {
#pragma unroll
    for (int d = 1; d < 64; d <<= 1) v += __shfl_xor(v, d);
    return v;
}

DI void ph0_rows(const Params& P, float* Wl) {
    const int tid = opaque_tid(), lane = tid & 63, w = tid >> 6;
#pragma unroll 8
    for (int i = tid; i < 8192; i += 256) { const int k = i >> 3, j = i & 7; Wl[j * 1024 + k] = P.w_in[(size_t)k * 3080 + 1536 + j] * P.norm_w[k]; }
    __syncthreads();
    for (int row0 = (blockIdx.x * 4 + w) * 2; row0 < T_ALL; row0 += gridDim.x * 8) {
        f32x4 xv[2][4]; float d[2][8], ss[2];
#pragma unroll
        for (int rr = 0; rr < 2; ++rr) {
            const int row = row0 + rr;
            const float* xr = row < NP ? P.x_prompt + (size_t)row * 1024 : P.x_sample + (size_t)(row - NP) * 1024;
#pragma unroll
            for (int q = 0; q < 4; ++q) xv[rr][q] = *(const f32x4*)(xr + q * 256 + lane * 4);
            ss[rr] = 0.f;
#pragma unroll
            for (int j = 0; j < 8; ++j) d[rr][j] = 0.f;
        }
#pragma unroll
        for (int q = 0; q < 4; ++q) {
#pragma unroll
            for (int j = 0; j < 8; ++j) {
                const f32x4 wv = *(const f32x4*)(Wl + j * 1024 + q * 256 + lane * 4);
#pragma unroll
                for (int rr = 0; rr < 2; ++rr) d[rr][j] += xv[rr][q][0] * wv[0] + xv[rr][q][1] * wv[1] + xv[rr][q][2] * wv[2] + xv[rr][q][3] * wv[3];
            }
#pragma unroll
            for (int rr = 0; rr < 2; ++rr) ss[rr] += xv[rr][q][0] * xv[rr][q][0] + xv[rr][q][1] * xv[rr][q][1] + xv[rr][q][2] * xv[rr][q][2] + xv[rr][q][3] * xv[rr][q][3];
        }
#pragma unroll
        for (int sft = 1; sft < 64; sft <<= 1) {
#pragma unroll
            for (int rr = 0; rr < 2; ++rr) {
                ss[rr] += __shfl_xor(ss[rr], sft);
#pragma unroll
                for (int j = 0; j < 8; ++j) d[rr][j] += __shfl_xor(d[rr][j], sft);
            }
        }
#pragma unroll
        for (int rr = 0; rr < 2; ++rr) {
            const int row = row0 + rr;
            const float rstd = rsqrtf(ss[rr] * (1.f / 1024.f) + 1e-6f);
#pragma unroll
            for (int q = 0; q < 4; ++q) {
                u32x2 o; o[0] = pk2(xv[rr][q][0] * rstd, xv[rr][q][1] * rstd); o[1] = pk2(xv[rr][q][2] * rstd, xv[rr][q][3] * rstd);
                *(u32x2*)(P.xb + (size_t)row * 1024 + q * 256 + lane * 4) = o;
            }
            if (lane < 8) {
                float y = d[rr][0];
#pragma unroll
                for (int j = 1; j < 8; ++j) y = (lane == j) ? d[rr][j] : y;
                y *= rstd;
                float o;
                if (lane < 4) { const float a = y + P.dt_bias[lane]; const float sp = fmaxf(a, 0.f) + log1pf(expf(-fabsf(a))); o = -expf(P.A_log[lane]) * sp; }
                else o = 1.f / (1.f + expf(-y));
                P.gbeta[(size_t)row * 8 + lane] = o;
            }
        }
    }
}

DI f32x8 load8(const Params& P, bool first, bool sample, int sb, int row0, int tt, int col) {
    f32x8 o;
    if (tt >= 0 || !first) {
        const u32x4 v = *(const u32x4*)(P.p + (size_t)(row0 + tt) * 3072 + col);
#pragma unroll
        for (int i = 0; i < 4; ++i) { o[2 * i] = bflo(v[i]); o[2 * i + 1] = bfhi(v[i]); }
    } else if (sample) {
        const float* c = P.cache_conv + (size_t)(sb * 3 + 3 + tt) * 1536 + col;
        const f32x4 a = *(const f32x4*)c, b = *(const f32x4*)(c + 4);
#pragma unroll
        for (int i = 0; i < 4; ++i) { o[i] = a[i]; o[4 + i] = b[i]; }
    } else {
#pragma unroll
        for (int i = 0; i < 8; ++i) o[i] = 0.f;
    }
    return o;
}
DI float load1(const Params& P, bool first, bool sample, int sb, int row0, int tt, int col) {
    if (tt >= 0 || !first) return bf2f(P.p[(size_t)(row0 + tt) * 3072 + col]);
    if (sample) return P.cache_conv[(size_t)(sb * 3 + 3 + tt) * 1536 + col];
    return 0.f;
}
DI u32x4 ld_pair(const u16* ptr) { const u32x2 lo = *(const u32x2*)ptr, hi = *(const u32x2*)(ptr + 8); u32x4 r; r[0] = lo[0]; r[1] = lo[1]; r[2] = hi[0]; r[3] = hi[1]; return r; }

DI f32x8 load8p(const Params& P, int row0, int tt, int col) {
    f32x8 o; const u32x4 v = *(const u32x4*)(P.p + (size_t)(row0 + tt) * 3072 + col);
#pragma unroll
    for (int i = 0; i < 4; ++i) { o[2 * i] = bflo(v[i]); o[2 * i + 1] = bfhi(v[i]); }
    return o;
}
template <bool FAST>
DI void d1_conv_qk(const Params& P, bool sample, int sb, int row0, int L, int h, int tid, u16* Qs, u16* Ks, u16* Kt) {
    const int c8 = tid & 15;
#pragma unroll
    for (int X = 0; X < 2; ++X) {
        const int col = X * 512 + h * 128 + c8 * 8;
        f32x4 cw[4][2];
#pragma unroll
        for (int tap = 0; tap < 4; ++tap) { cw[tap][0] = *(const f32x4*)(P.conv_w + tap * 1536 + col); cw[tap][1] = *(const f32x4*)(P.conv_w + tap * 1536 + col + 4); }
        u32x4 raw[4][4];
        if (FAST) {
#pragma unroll
            for (int pass = 0; pass < 4; ++pass)
#pragma unroll
                for (int tap = 0; tap < 4; ++tap) raw[pass][tap] = *(const u32x4*)(P.p + (size_t)(row0 + ((pass * 256 + tid) >> 4) - 3 + tap) * 3072 + col);
        }
#pragma unroll
        for (int pass = 0; pass < 4; ++pass) {
            const int j = (pass * 256 + tid) >> 4;
            f32x8 acc; for (int e = 0; e < 8; ++e) acc[e] = 0.f;
            {
                u32x4 pv[4]; f32x4 ca[4], cb[4];
                if (!FAST) {
#pragma unroll
                    for (int tap = 0; tap < 4; ++tap) {
                        const int tt = j - 3 + tap;
                        pv[tap] = *(const u32x4*)(P.p + (size_t)(row0 + (tt > 0 ? tt : 0)) * 3072 + col);
                        const int cr = 3 + tt < 0 ? 0 : (3 + tt > 2 ? 2 : 3 + tt);
                        const float* cp = P.cache_conv + (size_t)((sample ? sb : 0) * 3 + cr) * 1536 + col;
                        ca[tap] = *(const f32x4*)cp; cb[tap] = *(const f32x4*)(cp + 4);
                    }
                }
#pragma unroll
                for (int tap = 0; tap < 4; ++tap) {
                    f32x8 in;
                    if (FAST) {
#pragma unroll
                        for (int i = 0; i < 4; ++i) { in[2 * i] = bflo(raw[pass][tap][i]); in[2 * i + 1] = bfhi(raw[pass][tap][i]); }
                    } else {
                        const bool hist = (j - 3 + tap) >= 0;
#pragma unroll
                        for (int i = 0; i < 4; ++i) {
                            const float c0 = i < 2 ? ca[tap][2 * i] : cb[tap][2 * i - 4], c1 = i < 2 ? ca[tap][2 * i + 1] : cb[tap][2 * i - 3];
                            in[2 * i] = hist ? bflo(pv[tap][i]) : (sample ? c0 : 0.f); in[2 * i + 1] = hist ? bfhi(pv[tap][i]) : (sample ? c1 : 0.f);
                        }
                    }
#pragma unroll
                    for (int e = 0; e < 4; ++e) { acc[e] += in[e] * cw[tap][0][e]; acc[4 + e] += in[4 + e] * cw[tap][1][e]; }
                }
#pragma unroll
                for (int e = 0; e < 8; ++e) acc[e] = (FAST || j < L) ? silu_f(acc[e]) : 0.f;
            }
            float ss = 0.f;
#pragma unroll
            for (int e = 0; e < 8; ++e) ss += acc[e] * acc[e];
            ss += __shfl_xor(ss, 1); ss += __shfl_xor(ss, 2); ss += __shfl_xor(ss, 4); ss += __shfl_xor(ss, 8);
            const float sc = rsqrtf(ss + 1e-6f) * (X == 0 ? 0.08838834764831845f : 1.f);
            u32x4 pk;
#pragma unroll
            for (int e = 0; e < 4; ++e) pk[e] = pk2(acc[2 * e] * sc, acc[2 * e + 1] * sc);
            if (X == 0) *(u32x4*)(Qs + j * 136 + c8 * 8) = pk;
            else {
                *(u32x4*)(Ks + j * 136 + c8 * 8) = pk;
#pragma unroll
                for (int e = 0; e < 4; ++e) { Kt[(c8 * 8 + 2 * e) * 72 + j] = (u16)(pk[e] & 0xffffu); Kt[(c8 * 8 + 2 * e + 1) * 72 + j] = (u16)(pk[e] >> 16); }
            }
        }
    }
}

template <bool FAST>
DI void d1_conv_v(const Params& P, bool sample, int sb, int row0, int L, int h, int tid, u32x4 (&vpk)[4]) {
    const bool first = true;
#pragma unroll
    for (int pass = 0; pass < 4; ++pass) {
        const int it = pass * 256 + tid, e = it & 127, j0 = (it >> 7) * 8;
        const int col = 1024 + h * 128 + e;
        float in[11];
#pragma unroll
        for (int r = 0; r < 11; ++r) { const int tt = j0 - 3 + r; if (FAST) in[r] = bf2f(P.p[(size_t)(row0 + tt) * 3072 + col]);
            else {
                const float pvv = bf2f(P.p[(size_t)(row0 + (tt > 0 ? tt : 0)) * 3072 + col]);
                const int cr = 3 + tt < 0 ? 0 : (3 + tt > 2 ? 2 : 3 + tt);
                const float cv = P.cache_conv[(size_t)((sample ? sb : 0) * 3 + cr) * 1536 + col];
                in[r] = tt >= 0 ? pvv : (sample ? cv : 0.f);
            } }
        float cw[4];
#pragma unroll
        for (int tap = 0; tap < 4; ++tap) cw[tap] = P.conv_w[tap * 1536 + col];
        float o[8];
#pragma unroll
        for (int jj = 0; jj < 8; ++jj) {
            float s = 0.f;
#pragma unroll
            for (int tap = 0; tap < 4; ++tap) s += in[jj + tap] * cw[tap];
            o[jj] = (FAST || j0 + jj < L) ? silu_f(s) : 0.f;
        }
        u32x4 pk;
#pragma unroll
        for (int q = 0; q < 4; ++q) pk[q] = pk2(o[2 * q], o[2 * q + 1]);
        vpk[pass] = pk;
    }
}

DI void d1_item(const Params& P, int item, char* smem) {
    const int tid = opaque_tid(), lane = tid & 63, w = tid >> 6, l31 = lane & 31, hh = lane >> 5;
    const int slot = item >> 2, h = item & 3;
    int row0, L; slot_info(slot, row0, L);
    const bool sample = slot >= 512; const int sb = slot - 512;
    const bool first = sample || ((slot & 255) == 0);
    u16* Qs = (u16*)smem;
    u16* Kt = Qs + 64 * 136;
    u16* R1 = Kt + 128 * 72;
    u16* R2 = R1 + 9216;
    float* sm = (float*)(R2 + 9216);
    float *gcs = sm, *betas = sm + 64, *egc = sm + 128, *sdec = sm + 192;
    u16* Ks = R1; float* Af = (float*)R2;

    if (w == 0) {
        float g = 0.f, be = 0.f;
        if (lane < L) { g = P.gbeta[(size_t)(row0 + lane) * 8 + h]; be = P.gbeta[(size_t)(row0 + lane) * 8 + 4 + h]; }
        float c = g;
#pragma unroll
        for (int d = 1; d < 64; d <<= 1) { const float t = __shfl_up(c, d); if (lane >= d) c += t; }
        const float gl = __shfl(c, 63);
        gcs[lane] = c; betas[lane] = be; egc[lane] = expf(c); sdec[lane] = expf(gl - c);
        if (lane == 0) sm[256] = expf(gl);
    }
    if (!first) d1_conv_qk<true>(P, sample, sb, row0, L, h, tid, Qs, Ks, Kt); else d1_conv_qk<false>(P, sample, sb, row0, L, h, tid, Qs, Ks, Kt);
    __syncthreads();
    unsigned atp[2][8];
    {
        const int mt = w & 1; const u16* Asrc = (w < 2) ? Ks : Qs;
        f32x16 accm[2]; accm[0] = zero16(); accm[1] = zero16();
#pragma unroll 2
        for (int s = 0; s < 8; ++s) {
            const u32x4 a = *(const u32x4*)(Asrc + (32 * mt + l31) * 136 + 16 * s + 8 * hh);
            const u32x4 b0 = *(const u32x4*)(Ks + l31 * 136 + 16 * s + 8 * hh), b1 = *(const u32x4*)(Ks + (32 + l31) * 136 + 16 * s + 8 * hh);
            accm[0] = MFMA32(a, b0, accm[0]); accm[1] = MFMA32(a, b1, accm[1]);
        }
        __builtin_amdgcn_sched_barrier(0);
#pragma unroll
        for (int nt = 0; nt < 2; ++nt) {
            const int j = 32 * nt + l31;
            const float gj = gcs[j];
#pragma unroll
            for (int q = 0; q < 4; ++q) {
                const int i0 = 32 * mt + 8 * q + 4 * hh;
                const f32x4 gi = *(const f32x4*)(gcs + i0), bi = *(const f32x4*)(betas + i0);
#pragma unroll
                for (int e = 0; e < 4; ++e) {
                    const int r = 4 * q + e;
                    const float dij = (float)(i0 + e - j);
                    const float dec = __expf(fminf(gi[e] - gj, 0.f)) * fminf(fmaxf(dij + 1.f, 0.f), 1.f);
                    const float v = accm[nt][r] * dec;
                    if (w < 2) Af[(i0 + e) * 64 + j] = bi[e] * v * fminf(fmaxf(dij, 0.f), 1.f);
                    const unsigned hb = f2bf(v);
                    if (e & 1) atp[nt][r >> 1] |= hb << 16; else atp[nt][r >> 1] = hb;
                }
                __builtin_amdgcn_sched_barrier(0);
            }
        }
    }
    __syncthreads();
    u32x4 vpk[4];
    if (w != 0) { if (!first) d1_conv_v<true>(P, sample, sb, row0, L, h, tid, vpk); else d1_conv_v<false>(P, sample, sb, row0, L, h, tid, vpk); }
    if (w == 0) {
        const int bb = hh, c = l31;
        float tc[32];
        const float cf = (float)c;
        const float* Ab = Af + (32 * bb) * 64 + 32 * bb;
#pragma unroll
        for (int i = 0; i < 32; ++i) {
            float a[4] = {fmaxf(1.f - fabsf(cf - (float)i), 0.f), 0.f, 0.f, 0.f};
#pragma unroll
            for (int jq = 0; jq < (i + 3) / 4; ++jq) {
                const f32x4 a4 = *(const f32x4*)(Ab + i * 64 + 4 * jq);
#pragma unroll
                for (int e = 0; e < 4; ++e) if (4 * jq + e < i) a[e] -= a4[e] * tc[4 * jq + e];
            }
            tc[i] = (a[0] + a[1]) + (a[2] + a[3]);
        }
        u16* T11t = R1;
        u16* A21b = R1 + 32 * 40;
        u16* T22b = R1 + 64 * 40;
        if (bb == 0) {
#pragma unroll
            for (int q = 0; q < 4; ++q) { u32x4 pk; for (int e = 0; e < 4; ++e) pk[e] = pk2(tc[8 * q + 2 * e], tc[8 * q + 2 * e + 1]); *(u32x4*)(T11t + c * 40 + 8 * q) = pk; }
        } else {
#pragma unroll
            for (int i = 0; i < 32; ++i) T22b[i * 40 + c] = f2bf(tc[i]);
        }
        {
            const float* src = Af + (32 + l31) * 64 + 16 * hh;
#pragma unroll
            for (int q = 0; q < 2; ++q) { const f32x4 v0 = *(const f32x4*)(src + 8 * q), v1 = *(const f32x4*)(src + 8 * q + 4); u32x4 pk; pk[0] = pk2(v0[0], v0[1]); pk[1] = pk2(v0[2], v0[3]); pk[2] = pk2(v1[0], v1[1]); pk[3] = pk2(v1[2], v1[3]); *(u32x4*)(A21b + l31 * 40 + 16 * hh + 8 * q) = pk; }
        }
        asm volatile("s_waitcnt lgkmcnt(0)" ::: "memory");
        f32x16 X = zero16();
#pragma unroll
        for (int s2 = 0; s2 < 2; ++s2) { const u32x4 a = *(const u32x4*)(A21b + l31 * 40 + 16 * s2 + 8 * hh), b = *(const u32x4*)(T11t + l31 * 40 + 16 * s2 + 8 * hh); X = MFMA32(a, b, X); }
        f32x16 Y = zero16();
#pragma unroll
        for (int s2 = 0; s2 < 2; ++s2) {
            u32x4 xb; for (int q = 0; q < 4; ++q) xb[q] = pk2(X[8 * s2 + 2 * q], X[8 * s2 + 2 * q + 1]);
            const u32x4 a = ld_pair(T22b + l31 * 40 + 16 * s2 + 4 * hh);
            Y = MFMA32(a, xb, Y);
        }
        asm volatile("s_waitcnt lgkmcnt(0)" ::: "memory");
        u16* T1 = R2; u16* T2 = R2 + 64 * 72;
        {
            const int col = 32 * bb + c;
            const float bc = betas[col], ec = bc * egc[col];
#pragma unroll
            for (int i = 0; i < 32; ++i) { T1[(32 * bb + i) * 72 + col] = f2bf(tc[i] * ec); T2[(32 * bb + i) * 72 + col] = f2bf(tc[i] * bc); }
            if (bb == 1) {
#pragma unroll
                for (int i = 0; i < 32; ++i) { T1[i * 72 + col] = 0; T2[i * 72 + col] = 0; }
            }
        }
        {
            const float bc = betas[l31], ec = bc * egc[l31];
#pragma unroll
            for (int r = 0; r < 16; ++r) { const int i = 32 + crow(r, hh); T1[i * 72 + l31] = f2bf(-Y[r] * ec); T2[i * 72 + l31] = f2bf(-Y[r] * bc); }
        }
    }
    __syncthreads();
    if (w == 0) { if (!first) d1_conv_v<true>(P, sample, sb, row0, L, h, tid, vpk); else d1_conv_v<false>(P, sample, sb, row0, L, h, tid, vpk); }
#pragma unroll
    for (int pass = 0; pass < 4; ++pass) { const int it = pass * 256 + tid; *(u32x4*)(R1 + (it & 127) * 72 + (it >> 7) * 8) = vpk[pass]; }
    __syncthreads();
    f32x16 wu[2][2];
    const int cb = (w & 1) * 64;
    {
        const u16* Ts = (w < 2) ? R2 : R2 + 64 * 72;
        const u16* Bsrc = (w < 2) ? Kt : R1;
#pragma unroll
        for (int m = 0; m < 2; ++m)
#pragma unroll
            for (int n = 0; n < 2; ++n) wu[m][n] = zero16();
#pragma unroll
        for (int s = 0; s < 4; ++s) {
            u32x4 a[2], b[2];
#pragma unroll
            for (int m = 0; m < 2; ++m) a[m] = *(const u32x4*)(Ts + (32 * m + l31) * 72 + 16 * s + 8 * hh);
#pragma unroll
            for (int n = 0; n < 2; ++n) b[n] = *(const u32x4*)(Bsrc + (cb + 32 * n + l31) * 72 + 16 * s + 8 * hh);
#pragma unroll
            for (int m = 0; m < 2; ++m)
#pragma unroll
                for (int n = 0; n < 2; ++n) wu[m][n] = MFMA32(a[m], b[n], wu[m][n]);
        }
    }
    __syncthreads();
    if (w >= 2) {
        const int mt = w & 1;
#pragma unroll
        for (int nt = 0; nt < 2; ++nt)
#pragma unroll
            for (int r = 0; r < 16; ++r) R2[(32 * mt + crow(r, hh)) * 72 + 32 * nt + l31] = (u16)((r & 1) ? (atp[nt][r >> 1] >> 16) : (atp[nt][r >> 1] & 0xffffu));
    }
    __syncthreads();
    u32x4 fu[2][2][2], fs[2][2][2];
#pragma unroll
    for (int m = 0; m < 2; ++m)
#pragma unroll
        for (int n = 0; n < 2; ++n)
#pragma unroll
            for (int s2 = 0; s2 < 2; ++s2)
#pragma unroll
                for (int q = 0; q < 4; ++q) {
                    const int r = 8 * s2 + 2 * q;
                    const float v0 = wu[m][n][r], v1 = wu[m][n][r + 1];
                    const float s0 = sdec[32 * m + crow(r, hh)], s1 = sdec[32 * m + crow(r + 1, hh)];
                    fu[m][n][s2][q] = pk2(v0, v1); fs[m][n][s2][q] = pk2(v0 * s0, v1 * s1);
                }
    const u16* Att = R2;
    const size_t ib = (size_t)item;
    const float egl = sm[256];
    if (w < 2) {
#pragma unroll
        for (int nt = 0; nt < 2; ++nt)
#pragma unroll 1
            for (int dt = 0; dt < 4; ++dt) {
                f32x16 acc = zero16();
#pragma unroll
                for (int m = 0; m < 2; ++m)
#pragma unroll
                    for (int s2 = 0; s2 < 2; ++s2) { const u32x4 b = ld_pair(Kt + (32 * dt + l31) * 72 + 32 * m + 16 * s2 + 4 * hh); acc = MFMA32(fs[m][nt][s2], b, acc); }
                const int d = 32 * dt + l31;
#pragma unroll
                for (int q = 0; q < 4; ++q) {
                    const int dp0 = cb + 32 * nt + 8 * q + 4 * hh;
                    float v[4];
#pragma unroll
                    for (int i = 0; i < 4; ++i) v[i] = ((d == dp0 + i) ? egl : 0.f) - acc[4 * q + i];
                    u32x2 o; o[0] = pk2(v[0], v[1]); o[1] = pk2(v[2], v[3]);
                    *(u32x2*)(P.chP + ib * 16384 + (size_t)((((d >> 5) * 8 + (dp0 >> 4)) * 64 + ((dp0 >> 3) & 1) * 32 + (d & 31)) * 8 + (dp0 & 7))) = o;
                }
            }
#pragma unroll
        for (int nt = 0; nt < 2; ++nt)
#pragma unroll 1
            for (int it = 0; it < 2; ++it) {
                f32x16 acc = zero16();
#pragma unroll
                for (int m = 0; m < 2; ++m)
#pragma unroll
                    for (int s2 = 0; s2 < 2; ++s2) { const u32x4 b = ld_pair(Att + (32 * it + l31) * 72 + 32 * m + 16 * s2 + 4 * hh); acc = MFMA32(fu[m][nt][s2], b, acc); }
                const int i = 32 * it + l31;
                const float eg = egc[i];
#pragma unroll
                for (int q = 0; q < 4; ++q) {
                    const int dp0 = cb + 32 * nt + 8 * q + 4 * hh;
                    const u32x2 qv = *(const u32x2*)(Qs + i * 136 + dp0);
                    u32x2 o;
                    o[0] = pk2(bflo(qv[0]) * eg - acc[4 * q], bfhi(qv[0]) * eg - acc[4 * q + 1]);
                    o[1] = pk2(bflo(qv[1]) * eg - acc[4 * q + 2], bfhi(qv[1]) * eg - acc[4 * q + 3]);
                    *(u32x2*)(P.chQeff + ib * 8192 + (size_t)((((i >> 5) * 8 + (dp0 >> 4)) * 64 + ((dp0 >> 3) & 1) * 32 + (i & 31)) * 8 + (dp0 & 7))) = o;
                }
            }
    } else {
#pragma unroll 1
        for (int dt = 0; dt < 4; ++dt)
#pragma unroll
            for (int nt = 0; nt < 2; ++nt) {
                f32x16 acc = zero16();
#pragma unroll
                for (int m = 0; m < 2; ++m)
#pragma unroll
                    for (int s2 = 0; s2 < 2; ++s2) { const u32x4 a = ld_pair(Kt + (32 * dt + l31) * 72 + 32 * m + 16 * s2 + 4 * hh); acc = MFMA32(a, fs[m][nt][s2], acc); }
                const int e = cb + 32 * nt + l31;
#pragma unroll
                for (int q = 0; q < 4; ++q) {
                    const int d0 = 32 * dt + 8 * q + 4 * hh;
                    u32x2 o; o[0] = pk2(acc[4 * q], acc[4 * q + 1]); o[1] = pk2(acc[4 * q + 2], acc[4 * q + 3]);
                    *(u32x2*)(P.chQ + ib * 16384 + (size_t)(((((e >> 5) * 4 + dt) * 4 + q) * 64 + hh * 32 + (e & 31)) * 4)) = o;
                }
            }
#pragma unroll 1
        for (int it = 0; it < 2; ++it)
#pragma unroll
            for (int nt = 0; nt < 2; ++nt) {
                f32x16 acc = zero16();
#pragma unroll
                for (int m = 0; m < 2; ++m)
#pragma unroll
                    for (int s2 = 0; s2 < 2; ++s2) { const u32x4 a = ld_pair(Att + (32 * it + l31) * 72 + 32 * m + 16 * s2 + 4 * hh); acc = MFMA32(a, fu[m][nt][s2], acc); }
                const int e = cb + 32 * nt + l31;
#pragma unroll
                for (int q = 0; q < 4; ++q) {
                    const int i0 = 32 * it + 8 * q + 4 * hh;
                    u32x2 o; o[0] = pk2(acc[4 * q], acc[4 * q + 1]); o[1] = pk2(acc[4 * q + 2], acc[4 * q + 3]);
                    *(u32x2*)(P.chOl + ib * 8192 + (size_t)(((((e >> 5) * 2 + it) * 4 + q) * 64 + hh * 32 + (e & 31)) * 4)) = o;
                }
            }
    }
    __syncthreads();
}

DI void s5_wave(const Params& P, int slot, int g, int mode, u32x4* XsV) {
    unsigned* Xs = (unsigned*)XsV;
    const int lane = opaque_tid() & 63, l31 = lane & 31, hh = lane >> 5;
    int row0, L; slot_info(slot, row0, L);
    const int MT = L >> 5;
    float lr[2], li[2], l2r[2], l2i[2], l3r[2], l3i[2], l4r[2], l4i[2], Xr[2], Xi[2];
#pragma unroll
    for (int st = 0; st < 2; ++st) {
        const int n = 32 * st + l31;
        lr[st] = P.lbt[(g * 64 + n) * 2]; li[st] = P.lbt[(g * 64 + n) * 2 + 1];
        l2r[st] = lr[st] * lr[st] - li[st] * li[st]; l2i[st] = 2.f * lr[st] * li[st];
        l3r[st] = l2r[st] * lr[st] - l2i[st] * li[st]; l3i[st] = l2r[st] * li[st] + l2i[st] * lr[st];
        l4r[st] = l2r[st] * l2r[st] - l2i[st] * l2i[st]; l4i[st] = 2.f * l2r[st] * l2i[st];
        if (mode == 0) { Xr[st] = 0.f; Xi[st] = 0.f; }
        else if (slot < 512) { Xr[st] = P.carry[((size_t)(slot * 32 + g) * 64 + n) * 2]; Xi[st] = P.carry[((size_t)(slot * 32 + g) * 64 + n) * 2 + 1]; }
        else { Xr[st] = P.s5re0[((slot - 512) * 32 + g) * 64 + n]; Xi[st] = P.s5im0[((slot - 512) * 32 + g) * 64 + n]; }
    }
    u32x4 bfr[4];
#pragma unroll
    for (int nt = 0; nt < 4; ++nt) bfr[nt] = *(const u32x4*)(P.bbm + (size_t)(g * 128 + 32 * nt + l31) * 16 + 8 * hh);
#pragma unroll
    for (int m = 0; m < 2; ++m) {
        if (m < MT) {
            f32x16 bu[4];
            {
                const u32x4 a = *(const u32x4*)(P.p + (size_t)(row0 + 32 * m + l31) * 3072 + 2048 + 16 * g + 8 * hh);
#pragma unroll
                for (int nt = 0; nt < 4; ++nt) bu[nt] = MFMA32(a, bfr[nt], zero16());
            }
#pragma unroll
            for (int q = 0; q < 4; ++q)
#pragma unroll
                for (int st = 0; st < 2; ++st) {
                    float yr[4], yi[4];
                    yr[0] = bu[st][4 * q]; yi[0] = bu[st + 2][4 * q];
#pragma unroll
                    for (int r = 1; r < 4; ++r) {
                        yr[r] = lr[st] * yr[r - 1] - li[st] * yi[r - 1] + bu[st][4 * q + r];
                        yi[r] = lr[st] * yi[r - 1] + li[st] * yr[r - 1] + bu[st + 2][4 * q + r];
                    }
                    const float per = __shfl_xor(yr[3], 32), pei = __shfl_xor(yi[3], 32);
                    const float e0r = hh ? per : yr[3], e0i = hh ? pei : yi[3], e1r = hh ? yr[3] : per, e1i = hh ? yi[3] : pei;
                    const float xer = Xr[st], xei = Xi[st];
                    const float xor_ = l4r[st] * xer - l4i[st] * xei + e0r, xoi = l4r[st] * xei + l4i[st] * xer + e0i;
                    Xr[st] = l4r[st] * xor_ - l4i[st] * xoi + e1r; Xi[st] = l4r[st] * xoi + l4i[st] * xor_ + e1i;
                    if (mode) {
                        const float pr = hh ? xor_ : xer, pi = hh ? xoi : xei;
                        const int t0 = 32 * m + 8 * q + 4 * hh;
                        unsigned* xrow = Xs + t0 * 68 + 32 * st + l31;
                        xrow[0]       = pk2(yr[0] + lr[st] * pr - li[st] * pi,   yi[0] + lr[st] * pi + li[st] * pr);
                        xrow[68]      = pk2(yr[1] + l2r[st] * pr - l2i[st] * pi, yi[1] + l2r[st] * pi + l2i[st] * pr);
                        xrow[2 * 68]  = pk2(yr[2] + l3r[st] * pr - l3i[st] * pi, yi[2] + l3r[st] * pi + l3i[st] * pr);
                        xrow[3 * 68]  = pk2(yr[3] + l4r[st] * pr - l4i[st] * pi, yi[3] + l4r[st] * pi + l4i[st] * pr);
                    }
                }
        }
    }
    if (mode == 0) {
        if (hh == 0) {
#pragma unroll
            for (int st = 0; st < 2; ++st) { const int n = 32 * st + l31; P.E[((size_t)(slot * 32 + g) * 64 + n) * 2] = Xr[st]; P.E[((size_t)(slot * 32 + g) * 64 + n) * 2 + 1] = Xi[st]; }
        }
        return;
    }
    if (slot >= 512 && hh == 0) {
#pragma unroll
        for (int st = 0; st < 2; ++st) { const int n = 32 * st + l31; P.out[O_RE_S + ((slot - 512) * 32 + g) * 64 + n] = Xr[st]; P.out[O_IM_S + ((slot - 512) * 32 + g) * 64 + n] = Xi[st]; }
    }
    asm volatile("s_waitcnt lgkmcnt(0)" ::: "memory");
    const int l15 = lane & 15, lq = lane >> 4;
    u32x4 cf[4];
#pragma unroll
    for (int ks = 0; ks < 4; ++ks) cf[ks] = *(const u32x4*)(P.Cm + (size_t)(g * 16 + l15) * 128 + 32 * ks + 8 * lq);
    const float Dv = P.Dp[16 * g + l15];
    const u16* Xh = (const u16*)Xs;
#pragma unroll
    for (int m4 = 0; m4 < 4; ++m4) {
        if (m4 < 2 * MT) {
            f32x4 ya = {0.f, 0.f, 0.f, 0.f};
#pragma unroll
            for (int ks = 0; ks < 4; ++ks) { const u32x4 a = *(const u32x4*)(Xh + (16 * m4 + l15) * 136 + 32 * ks + 8 * lq); ya = MFMA16(a, cf[ks], ya); }
            u16 uv[4];
#pragma unroll
            for (int r = 0; r < 4; ++r) uv[r] = P.p[(size_t)(row0 + 16 * m4 + 4 * lq + r) * 3072 + 2048 + 16 * g + l15];
#pragma unroll
            for (int r = 0; r < 4; ++r) P.p[(size_t)(row0 + 16 * m4 + 4 * lq + r) * 3072 + 16 * g + l15] = f2bf(gelu_f(ya[r] + Dv * bf2f(uv[r])));
        }
    }
    asm volatile("s_waitcnt lgkmcnt(0)" ::: "memory");
}

DI void chain_item(const Params& P, int it, char* smem) {
    const int tid = opaque_tid(), lane = tid & 63, w = tid >> 6, l31 = lane & 31, hh = lane >> 5;
    int es, h, nsteps, slot0; float* outp; f32x16 acc;
    if (it < 32) {
        const int bh = it >> 2; es = it & 3; const int b = bh >> 2; h = bh & 3; nsteps = 256; slot0 = b * 256;
        outp = P.out + O_DN_P + (size_t)(b * 4 + h) * 16384; acc = zero16();
    } else {
        const int j = it - 32, bh = j >> 2; es = j & 3; const int b = bh >> 2; h = bh & 3; nsteps = 1; slot0 = 512 + b;
        outp = P.out + O_DN_S + (size_t)(b * 4 + h) * 16384;
        const float* s0 = P.state_dn + (size_t)(b * 4 + h) * 16384;
#pragma unroll
        for (int r = 0; r < 16; ++r) acc[r] = s0[(32 * w + crow(r, hh)) * 128 + 32 * es + l31];
    }
    u16* Sb = (u16*)smem;
    const size_t poff = (size_t)(w * 8 * 64 + lane) * 8;
    const size_t qoff = (size_t)((es * 4 + w) * 4 * 64 + lane) * 4;
    const size_t soff = (size_t)(((es * 8 + (tid & 7)) * 64 + (tid >> 3)) * 8);
    constexpr int DEPTH = 4;
    u32x4 pa[DEPTH][8]; u32x2 qm[DEPTH][4];
#pragma unroll
    for (int i = 0; i < DEPTH; ++i) {
        if (i < nsteps) {
            const size_t ib = (size_t)(slot0 + i) * 4 + h;
#pragma unroll
            for (int s = 0; s < 8; ++s) pa[i][s] = *(const u32x4*)(P.chP + ib * 16384 + poff + 512 * s);
#pragma unroll
            for (int q = 0; q < 4; ++q) qm[i][q] = *(const u32x2*)(P.chQ + ib * 16384 + qoff + 256 * q);
        } else {
#pragma unroll
            for (int s = 0; s < 8; ++s) pa[i][s] = (u32x4){0u, 0u, 0u, 0u};
#pragma unroll
            for (int q = 0; q < 4; ++q) qm[i][q] = (u32x2){0u, 0u};
        }
    }
    for (int c0 = 0; c0 < nsteps; c0 += DEPTH) {
#pragma unroll
        for (int i = 0; i < DEPTH; ++i) {
            const int c = c0 + i;
            if (c < nsteps) {
                const size_t ib = (size_t)(slot0 + c) * 4 + h;
                u16* sb = Sb + (c & 1) * 32 * 136;
#pragma unroll
                for (int q = 0; q < 4; ++q) {
                    u32x2 o; o[0] = pk2(acc[4 * q], acc[4 * q + 1]); o[1] = pk2(acc[4 * q + 2], acc[4 * q + 3]);
                    *(u32x2*)(sb + l31 * 136 + 32 * w + 8 * q + 4 * hh) = o;
                }
                asm volatile("s_waitcnt lgkmcnt(0)\n\ts_barrier" ::: "memory");
                {
                    const u32x4 s0 = *(const u32x4*)(sb + (tid >> 3) * 136 + (tid & 7) * 16), s1 = *(const u32x4*)(sb + (tid >> 3) * 136 + (tid & 7) * 16 + 8);
                    *(u32x4*)(P.chS + ib * 16384 + soff) = s0; *(u32x4*)(P.chS + ib * 16384 + soff + 32 * 8) = s1;
                }
                f32x16 an0, an1 = zero16();
#pragma unroll
                for (int q = 0; q < 4; ++q) { an0[4 * q] = bflo(qm[i][q][0]); an0[4 * q + 1] = bfhi(qm[i][q][0]); an0[4 * q + 2] = bflo(qm[i][q][1]); an0[4 * q + 3] = bfhi(qm[i][q][1]); }
#pragma unroll
                for (int s = 0; s < 8; s += 2) {
                    const u32x4 b0 = *(const u32x4*)(sb + l31 * 136 + 16 * s + 8 * hh), b1 = *(const u32x4*)(sb + l31 * 136 + 16 * s + 16 + 8 * hh);
                    an0 = MFMA32(pa[i][s], b0, an0); an1 = MFMA32(pa[i][s + 1], b1, an1);
                }
#pragma unroll
                for (int r = 0; r < 16; ++r) acc[r] = an0[r] + an1[r];
                if (c + DEPTH < nsteps) {
                    const size_t ibn = ib + 4 * DEPTH;
#pragma unroll
                    for (int s = 0; s < 8; ++s) pa[i][s] = *(const u32x4*)(P.chP + ibn * 16384 + poff + 512 * s);
#pragma unroll
                    for (int q = 0; q < 4; ++q) qm[i][q] = *(const u32x2*)(P.chQ + ibn * 16384 + qoff + 256 * q);
                }
            }
        }
    }
#pragma unroll
    for (int r = 0; r < 16; ++r) outp[(32 * w + crow(r, hh)) * 128 + 32 * es + l31] = acc[r];
    __syncthreads();
}

DI void s5_carry(const Params& P, int idx) {
    const int b = idx >> 11, gn = idx & 2047;
    const float ar = P.lb64[gn * 2], ai = P.lb64[gn * 2 + 1];
    const f32x2* __restrict__ Ep = (const f32x2*)P.E + (size_t)b * 256 * 2048 + gn;
    f32x2* __restrict__ Cp = (f32x2*)P.carry + (size_t)b * 256 * 2048 + gn;
    float xr = 0.f, xi = 0.f;
    for (int c0 = 0; c0 < 256; c0 += 16) {
        f32x2 e[16];
#pragma unroll
        for (int i = 0; i < 16; ++i) e[i] = Ep[(size_t)(c0 + i) * 2048];
#pragma unroll
        for (int i = 0; i < 16; ++i) {
            f32x2 o; o[0] = xr; o[1] = xi; Cp[(size_t)(c0 + i) * 2048] = o;
            const float nr = ar * xr - ai * xi + e[i][0], ni = ar * xi + ai * xr + e[i][1];
            xr = nr; xi = ni;
        }
    }
    P.out[O_RE_P + b * 2048 + gn] = xr; P.out[O_IM_P + b * 2048 + gn] = xi;
}

struct EpiP { u16* p; DI void operator()(int rbase, int col, int hh, const f32x16& v) const {
#pragma unroll
    for (int r = 0; r < 16; ++r) p[(size_t)(rbase + crow(r, hh)) * 3072 + col] = f2bf(v[r]); } };
struct EpiGlu { u16* prow; const float* gb; int L; int n0; DI void operator()(int rbase, int col, int hh, const f32x16& v) const {
    const int n = n0 + col; const float bias = gb[n];
#pragma unroll
    for (int r = 0; r < 16; ++r) { const int i = rbase + crow(r, hh);
        if (i < L) { u16* pr = prow + (size_t)i * 3072; const float gy = bf2f(pr[n]), z = bf2f(pr[2560 + n]); pr[1024 + n] = f2bf(gy * sigmoid_f(v[r] + bias) * silu_f(z)); } } } };
struct EpiOut { const float* x; float* y; int L; int n0; DI void operator()(int rbase, int col, int hh, const f32x16& v) const {
    const int n = n0 + col;
#pragma unroll
    for (int r = 0; r < 16; ++r) { const int i = rbase + crow(r, hh); if (i < L) y[(size_t)i * 1024 + n] = x[(size_t)i * 1024 + n] + v[r]; } } };

DI void f3_delta(const Params& P, int slot, int row0, int L, int h, int m) {
    const int tid = opaque_tid(), lane = tid & 63, l31 = lane & 31, hh = lane >> 5;
    if (32 * m >= L) return;
    const size_t ib = (size_t)slot * 4 + h;
    const u16* Qe = P.chQeff + ib * 8192; const u16* Sa = P.chS + ib * 16384; const u16* Ol = P.chOl + ib * 8192;
    f32x16 o[4];
#pragma unroll
    for (int nt = 0; nt < 4; ++nt)
#pragma unroll
        for (int q = 0; q < 4; ++q) {
            const u32x2 v = *(const u32x2*)(Ol + (size_t)((((nt * 2 + m) * 4 + q) * 64 + lane) * 4));
            o[nt][4 * q] = bflo(v[0]); o[nt][4 * q + 1] = bfhi(v[0]); o[nt][4 * q + 2] = bflo(v[1]); o[nt][4 * q + 3] = bfhi(v[1]);
        }
#pragma unroll 4
    for (int s = 0; s < 8; ++s) {
        const u32x4 a = *(const u32x4*)(Qe + (size_t)(((m * 8 + s) * 64 + lane) * 8));
        u32x4 b[4];
#pragma unroll
        for (int nt = 0; nt < 4; ++nt) b[nt] = *(const u32x4*)(Sa + (size_t)(((nt * 8 + s) * 64 + lane) * 8));
#pragma unroll
        for (int nt = 0; nt < 4; ++nt) o[nt] = MFMA32(a, b[nt], o[nt]);
    }
    float nw[4];
#pragma unroll
    for (int nt = 0; nt < 4; ++nt) nw[nt] = P.dn_norm_w[32 * nt + l31];
    u16 zv[16][4];
#pragma unroll
    for (int r = 0; r < 16; ++r) {
        const u16* pr = P.p + (size_t)(row0 + 32 * m + crow(r, hh)) * 3072 + 1536 + h * 128 + l31;
#pragma unroll
        for (int nt = 0; nt < 4; ++nt) zv[r][nt] = pr[32 * nt];
    }
#pragma unroll
    for (int r = 0; r < 16; ++r) {
        float ss = 0.f;
#pragma unroll
        for (int nt = 0; nt < 4; ++nt) ss += o[nt][r] * o[nt][r];
        ss += __shfl_xor(ss, 1); ss += __shfl_xor(ss, 2); ss += __shfl_xor(ss, 4); ss += __shfl_xor(ss, 8); ss += __shfl_xor(ss, 16);
        const float rs = rsqrtf(ss * (1.f / 128.f) + 1e-6f);
        u16* pr = P.p + (size_t)(row0 + 32 * m + crow(r, hh)) * 3072 + 512 + h * 128 + l31;
#pragma unroll
        for (int nt = 0; nt < 4; ++nt) pr[32 * nt] = f2bf(o[nt][r] * rs * nw[nt] * silu_f(bf2f(zv[r][nt])));
    }
}

DI void mixer_s5_item(const Params& P, int item, char* smem) {
    const int tid = opaque_tid(), w = tid >> 6;
    const int slot = item >> 2, qt = item & 3;
    u32x4* xs = (u32x4*)(smem + w * 17408);
    s5_wave(P, slot, 8 * qt + w, 1, xs);
    s5_wave(P, slot, 8 * qt + 4 + w, 1, xs);
}
DI void mixer_dn_item(const Params& P, int item) {
    const int tid = opaque_tid(), w = tid >> 6;
    const int slot = item >> 1, hp = item & 1;
    int row0, L; slot_info(slot, row0, L);
    f3_delta(P, slot, row0, L, 2 * hp + (w >> 1), w & 1);
}
struct EpiGluT { u16* prow; const float* gb; int n0; DI void operator()(int rbase, int col, int hh, const f32x16& v) const {
    const int n = n0 + col; const float bias = gb[n];
    u16 gyv[16], zv[16];
#pragma unroll
    for (int r = 0; r < 16; ++r) { const u16* pr = prow + (size_t)(rbase + crow(r, hh)) * 3072; gyv[r] = pr[n]; zv[r] = pr[2560 + n]; }
#pragma unroll
    for (int r = 0; r < 16; ++r) { u16* pr = prow + (size_t)(rbase + crow(r, hh)) * 3072; pr[1024 + n] = f2bf(bf2f(gyv[r]) * sigmoid_f(v[r] + bias) * silu_f(bf2f(zv[r]))); } } };
struct EpiOutT { const float* x; float* y; int n0; DI void operator()(int rbase, int col, int hh, const f32x16& v) const {
    const int n = n0 + col;
    float xv[16];
#pragma unroll
    for (int r = 0; r < 16; ++r) xv[r] = x[(size_t)(rbase + crow(r, hh)) * 1024 + n];
#pragma unroll
    for (int r = 0; r < 16; ++r) y[(size_t)(rbase + crow(r, hh)) * 1024 + n] = xv[r] + v[r]; } };
DI void norm_rows(const Params& P, int G, int B) {
    const int tid = opaque_tid(), lane = tid & 63, w = tid >> 6;
    f32x4 fw[4];
#pragma unroll
    for (int q = 0; q < 4; ++q) fw[q] = *(const f32x4*)(P.fnorm_w + q * 256 + lane * 4);
    for (int row0 = (B * 4 + w) * 2; row0 < T_ALL; row0 += G * 8) {
        f32x4 v[2][4]; float ss[2];
#pragma unroll
        for (int rr = 0; rr < 2; ++rr) {
            const float* r = P.out + O_Y + (size_t)(row0 + rr) * 1024;
#pragma unroll
            for (int q = 0; q < 4; ++q) v[rr][q] = *(const f32x4*)(r + q * 256 + lane * 4);
        }
#pragma unroll
        for (int rr = 0; rr < 2; ++rr) {
            ss[rr] = 0.f;
#pragma unroll
            for (int q = 0; q < 4; ++q) ss[rr] += v[rr][q][0] * v[rr][q][0] + v[rr][q][1] * v[rr][q][1] + v[rr][q][2] * v[rr][q][2] + v[rr][q][3] * v[rr][q][3];
        }
#pragma unroll
        for (int sft = 1; sft < 64; sft <<= 1) { ss[0] += __shfl_xor(ss[0], sft); ss[1] += __shfl_xor(ss[1], sft); }
#pragma unroll
        for (int rr = 0; rr < 2; ++rr) {
            float* r = P.out + O_Y + (size_t)(row0 + rr) * 1024;
            const float rs = rsqrtf(ss[rr] * (1.f / 1024.f) + 1e-6f);
#pragma unroll
            for (int q = 0; q < 4; ++q) { f32x4 o; for (int e = 0; e < 4; ++e) o[e] = v[rr][q][e] * rs * fw[q][e]; *(f32x4*)(r + q * 256 + lane * 4) = o; }
        }
    }
}

#define XB_TMO      128
#define XB_XCNT(j)  (256  + 64 * (j))
#define XB_XSUB(j)  (1280 + 64 * (j))
#define XB_XGEN(j)  (2304 + 64 * (j))
#define XB_TOP      3328
#define XB_TOPGEN   3392
#define XCD_BAR_WORDS 3456
#define XB_SPIN_CAP (1u << 22)
#define LAS __attribute__((address_space(3)))
DI unsigned xb_ld(unsigned* p) { return __hip_atomic_load(p, __ATOMIC_RELAXED, __HIP_MEMORY_SCOPE_AGENT); }
DI unsigned xb_add(unsigned* p, unsigned v) { return __hip_atomic_fetch_add(p, v, __ATOMIC_RELAXED, __HIP_MEMORY_SCOPE_AGENT); }
DI unsigned xb_xcc_id() { return (unsigned)__builtin_amdgcn_s_getreg((3 << 11) | 20) & 0xFu; }
#define XB_SPIN(cond, bar) do { unsigned _sp = 0; while (cond) { __builtin_amdgcn_s_sleep(1); \
    if ((++_sp & 255u) == 0u) { if (xb_ld(&(bar)[XB_TMO])) break; if (_sp > XB_SPIN_CAP) { atomicAdd(&(bar)[XB_TMO], 1u); break; } } } } while (0)
struct XcdBarrier { unsigned* bar; unsigned x; volatile LAS unsigned* st; };
DI XcdBarrier xcd_barrier_post(unsigned* bar, volatile LAS unsigned* st) {
    XcdBarrier b; b.bar = bar; b.x = xb_xcc_id(); b.st = st;
    if (threadIdx.x == 0) (void)xb_add(&bar[XB_XCNT(b.x)], 1u);
    return b;
}
DI void xcd_barrier_complete(unsigned* bar, unsigned x, unsigned& nloc, unsigned& nx) {
    const unsigned G = gridDim.x * gridDim.y * gridDim.z;
    unsigned sum, cnt, mine, sp = 0u;
    for (;;) {
        sum = 0u; cnt = 0u; mine = 0u;
#pragma unroll
        for (unsigned j = 0; j < 16; ++j) { const unsigned c = xb_ld(&bar[XB_XCNT(j)]); sum += c; cnt += (c > 0u) ? 1u : 0u; mine = (j == x) ? c : mine; }
        if (sum == G) break;
        __builtin_amdgcn_s_sleep(1);
        if ((++sp & 255u) == 0u) { if (xb_ld(&bar[XB_TMO])) break; if (sp > XB_SPIN_CAP) { atomicAdd(&bar[XB_TMO], 1u); break; } }
    }
    nloc = mine > 0u ? mine : 1u; nx = cnt > 0u ? cnt : 1u;
}
DI void xcd_barrier(const XcdBarrier& b) {
    asm volatile("s_waitcnt vmcnt(0)" ::: "memory");
    __syncthreads();
    if (threadIdx.x == 0) {
        unsigned* bar = b.bar;
        __builtin_amdgcn_s_waitcnt(0);
        unsigned nloc = b.st[0], nx = b.st[1];
        if (nloc == 0u) { xcd_barrier_complete(bar, b.x, nloc, nx); b.st[0] = nloc; b.st[1] = nx; }
        const unsigned old = xb_add(&bar[XB_XSUB(b.x)], 1u);
        const unsigned gen = old / nloc;
        if (old + 1u == (gen + 1u) * nloc) {
            __builtin_amdgcn_fence(__ATOMIC_RELEASE, "agent");
            asm volatile("s_waitcnt vmcnt(0)" ::: "memory");
            const unsigned og = xb_add(&bar[XB_TOP], 1u);
            const unsigned tg = og / nx;
            if (og + 1u == (tg + 1u) * nx) xb_add(&bar[XB_TOPGEN], 1u);
            else XB_SPIN(xb_ld(&bar[XB_TOPGEN]) == tg, bar);
            __builtin_amdgcn_fence(__ATOMIC_ACQUIRE, "agent");
            xb_add(&bar[XB_XGEN(b.x)], 1u);
            asm volatile("s_waitcnt vmcnt(0)" ::: "memory");
        } else {
            XB_SPIN(xb_ld(&bar[XB_XGEN(b.x)]) == gen, bar);
            __builtin_amdgcn_fence(__ATOMIC_ACQUIRE, "agent");
            asm volatile("s_waitcnt vmcnt(0)" ::: "memory");
        }
    }
    __syncthreads();
}

#ifndef ONLY_PH
#define ONLY_PH -1
#endif
#define PH_ON(x) (ONLY_PH < 0 || ONLY_PH == (x))
__global__ void __launch_bounds__(256, 2) mega(Params P, int ph_lo, int ph_hi) {
    extern __shared__ __attribute__((aligned(16))) char smem[];
    const int G = gridDim.x, B = blockIdx.x;
    const bool multi = (ph_hi - ph_lo) > 1;
    __shared__ uint4 xb_words;
    if (threadIdx.x == 0) xb_words = make_uint4(0u, 0u, 0u, 0u);
    __syncthreads();
    XcdBarrier xb = xcd_barrier_post(P.bar, (volatile LAS unsigned*)&xb_words);
    if (ph_hi > 1000) cg::this_grid().sync();
    if (ph_lo <= 0 && ph_hi > 0 && PH_ON(0)) {
        const int tid = opaque_tid();
        for (int it = B; it < 1088 + 8; it += G) {
            if (it < 1088) ph0_transpose(P, it, (float*)smem);
            else ph0_s5const(P, (it - 1088) * 256 + tid);
        }
        __syncthreads();
        ph0_rows(P, (float*)smem);
    }
    if (multi) xcd_barrier(xb);
    if (ph_lo <= 1 && ph_hi > 1 && PH_ON(1)) {
        const int nwide = (260 * 12 / G) * G;
        for (int t = B; t < nwide; t += G) {
            const int mt = t / 12, nt = t % 12;
            EpiP epi{P.p + (size_t)mt * 128 * 3072 + nt * 256};
            gemm_tile_wide(P.xb + (size_t)mt * 128 * 1024, 1024, P.Wb1 + (size_t)nt * 256 * 1024, 1024, 1024, smem, epi);
        }
        for (int u = B; u < (260 * 12 - nwide) * 4; u += G) {
            const int t = nwide + (u >> 2), mt = t / 12, nt = (t % 12) * 2 + ((u >> 1) & 1), r0 = mt * 128 + (u & 1) * 64;
            EpiP epi{P.p + (size_t)r0 * 3072 + nt * 128};
            gemm_tile<64>(P.xb + (size_t)r0 * 1024, 1024, P.Wb1 + (size_t)nt * 128 * 1024, 1024, 1024, smem, epi);
        }
    }
    if (multi) xcd_barrier(xb);
    if (ph_lo <= 2 && ph_hi > 2 && PH_ON(2)) {
        if (G >= 304 + 32) {
            for (int it = B; it < 2048; it += G) d1_item(P, it, smem);
        } else {
            for (int it = B; it < NITEM; it += G) d1_item(P, it < 64 ? 2048 + it : it - 64, smem);
            const int w = opaque_tid() >> 6;
            for (int j = B; j < 4096; j += G) s5_wave(P, j >> 3, (j & 7) * 4 + w, 0, nullptr);
        }
        const int tid = opaque_tid();
        for (int i = B * 256 + tid; i < 18 * 3 * 1536; i += G * 256) {
            const int sq = i / 4608, rem = i % 4608, r = rem / 1536, c = rem % 1536;
            const int row = sq < 2 ? sq * 16384 + 16381 + r : NP + (sq - 2) * 32 + 29 + r;
            const float v = bf2f(P.p[(size_t)row * 3072 + c]);
            if (sq < 2) P.out[O_CONV_P + i] = v; else P.out[O_CONV_S + (i - 2 * 4608)] = v;
        }
    }
    if (multi) xcd_barrier(xb);
    if (ph_lo <= 3 && ph_hi > 3 && PH_ON(3)) {
        if (G >= 304 + 32) {
            if (B >= 32) {
                const int w = opaque_tid() >> 6;
                for (int j = B - 32; j < 4096; j += G - 32) s5_wave(P, j >> 3, (j & 7) * 4 + w, 0, nullptr);
                asm volatile("s_waitcnt vmcnt(0)" ::: "memory");
                __syncthreads();
                if (threadIdx.x == 0) { __builtin_amdgcn_fence(__ATOMIC_RELEASE, "agent"); asm volatile("s_waitcnt vmcnt(0)" ::: "memory"); xb_add(&P.bar[65], 1u); }
            }
            if (B < 32) chain_item(P, B, smem);
            else if (B < 288) { d1_item(P, 2048 + ((B - 32) >> 2), smem); chain_item(P, B, smem); }
            else if (B < 304) {
                if (threadIdx.x == 0) { unsigned sp = 0; while (xb_ld(&P.bar[65]) < (unsigned)(G - 32) && ++sp < (1u << 24)) __builtin_amdgcn_s_sleep(4); }
                __syncthreads();
                __builtin_amdgcn_fence(__ATOMIC_ACQUIRE, "agent");
                asm volatile("s_waitcnt vmcnt(0)" ::: "memory");
                __syncthreads();
                s5_carry(P, (B - 288) * 256 + opaque_tid());
                asm volatile("s_waitcnt vmcnt(0)" ::: "memory");
                __syncthreads();
                if (threadIdx.x == 0) { __builtin_amdgcn_fence(__ATOMIC_RELEASE, "agent"); asm volatile("s_waitcnt vmcnt(0)" ::: "memory"); xb_add(&P.bar[64], 1u); }
            }
            if (B >= 32 && (B < 288 || B >= 304)) {
                const int wi = B < 288 ? B - 32 : B - 304 + 256, nw = G - 48;
                if (threadIdx.x == 0) { unsigned sp = 0; while (xb_ld(&P.bar[64]) < 16u && ++sp < (1u << 24)) __builtin_amdgcn_s_sleep(4); }
                __syncthreads();
                __builtin_amdgcn_fence(__ATOMIC_ACQUIRE, "agent");
                asm volatile("s_waitcnt vmcnt(0)" ::: "memory");
                __syncthreads();
                for (int it = wi; it < NSLOT * 4; it += nw) mixer_s5_item(P, it, smem);
            }
        } else {
            for (int it = B; it < 288 + 16; it += G) {
                if (it < 288) chain_item(P, it, smem);
                else s5_carry(P, (it - 288) * 256 + opaque_tid());
            }
            __syncthreads();
        }
    }
    if (multi) xcd_barrier(xb);
    if (ph_lo <= 4 && ph_hi > 4 && PH_ON(4)) {
        if (G < 304 + 32) { xcd_barrier(xb); for (int it = B; it < NSLOT * 4; it += G) mixer_s5_item(P, it, smem); }
        for (int it = B; it < NSLOT * 2; it += G) mixer_dn_item(P, it);
    }
    if (multi && G < 304 + 32) xcd_barrier(xb);
    if (ph_lo <= 4 && ph_hi > 4 && PH_ON(4)) {
        for (int t = B; t < 260 * 4; t += G) {
            const int mt = t >> 2, nt = t & 3;
            EpiGluT epi{P.p + (size_t)mt * 128 * 3072, P.glu_b, nt * 128};
            gemm_tile<128>(P.p + (size_t)mt * 128 * 3072, 3072, P.Wb3 + (size_t)nt * 128 * 512, 512, 512, smem, epi);
        }
    }
    if (multi) xcd_barrier(xb);
    if (ph_lo <= 4 && ph_hi > 4 && PH_ON(4)) {
        const int nwide2 = (260 * 4 / G) * G;
        for (int t = B; t < nwide2; t += G) {
            const int mt = t >> 2, nt = t & 3;
            const int r0 = mt * 128;
            const float* xr = r0 < NP ? P.x_prompt + (size_t)r0 * 1024 : P.x_sample + (size_t)(r0 - NP) * 1024;
            EpiOutT epi{xr, P.out + O_Y + (size_t)r0 * 1024, nt * 256};
            gemm_tile_wide(P.p + (size_t)r0 * 3072 + 512, 3072, P.Wb2 + (size_t)nt * 256 * 1024, 1024, 1024, smem, epi);
        }
        for (int u = B; u < (260 * 4 - nwide2) * 4; u += G) {
            const int t = nwide2 + (u >> 2), mt = t >> 2, nt = (t & 3) * 2 + ((u >> 1) & 1);
            const int r0 = mt * 128 + (u & 1) * 64;
            const float* xr = r0 < NP ? P.x_prompt + (size_t)r0 * 1024 : P.x_sample + (size_t)(r0 - NP) * 1024;
            EpiOutT epi{xr, P.out + O_Y + (size_t)r0 * 1024, nt * 128};
            gemm_tile<64>(P.p + (size_t)r0 * 3072 + 512, 3072, P.Wb2 + (size_t)nt * 128 * 1024, 1024, 1024, smem, epi);
        }
    }
    if (multi) xcd_barrier(xb);
    if (ph_lo <= 4 && ph_hi > 4 && PH_ON(4)) norm_rows(P, G, B);
}

extern "C" void kernel_launch(void* const* d_in, const int* in_sizes, int n_in, void* d_out, int out_size, void* d_ws, size_t ws_size, hipStream_t stream) {
    static int grid = 0;
    if (grid == 0) {
        int dev = 0, cus = 0, per_cu = 0;
        hipGetDevice(&dev);
        hipDeviceGetAttribute(&cus, hipDeviceAttributeMultiprocessorCount, dev);
        if (hipFuncSetAttribute((const void*)mega, hipFuncAttributeMaxDynamicSharedMemorySize, LDS_BYTES) != hipSuccess) fprintf(stderr, "hipFuncSetAttribute failed\n");
        if (hipOccupancyMaxActiveBlocksPerMultiprocessor(&per_cu, (const void*)mega, 256, LDS_BYTES) != hipSuccess || per_cu < 1) { fprintf(stderr, "occupancy query failed (%d)\n", per_cu); per_cu = 1; }
        (void)hipGetLastError();
        if (per_cu > 2) per_cu = 2;
        grid = cus * per_cu;
        fprintf(stderr, "mega: cus %d per_cu %d grid %d ws %zu\n", cus, per_cu, grid, ws_size);
    }
    Params p{};
    const float** pin = (const float**)&p;
    for (int i = 0; i < 24; ++i) pin[i] = (const float*)d_in[i];
    p.out = (float*)d_out;
    char* ws = (char*)d_ws; size_t off = 0;
    auto take = [&](size_t bytes) { char* r = ws + off; off += (bytes + 255) & ~(size_t)255; return r; };
    p.bar = (unsigned*)take(XCD_BAR_WORDS * 4);
    p.Wb1 = (u16*)take((size_t)3072 * 1024 * 2);
    p.Wb2 = (u16*)take((size_t)1024 * 1024 * 2);
    p.Wb3 = (u16*)take((size_t)512 * 512 * 2);
    p.bbm = (u16*)take((size_t)32 * 128 * 16 * 2);
    p.Cm = (u16*)take((size_t)32 * 16 * 128 * 2);
    p.lbt = (float*)take(2048 * 2 * 4);
    p.lb64 = (float*)take(2048 * 2 * 4);
    p.gbeta = (float*)take((size_t)T_ALL * 8 * 4);
    p.E = (float*)take((size_t)512 * 2048 * 2 * 4);
    p.carry = (float*)take((size_t)512 * 2048 * 2 * 4);
    p.p = (u16*)take((size_t)(T_ALL + 64) * 3072 * 2);
    char* shared0 = ws + off;
    p.xb = (u16*)shared0;
    p.chP = (u16*)shared0;
    p.chQ = p.chP + (size_t)NITEM * 16384;
    p.chQeff = p.chQ + (size_t)NITEM * 16384;
    p.chOl = p.chQeff + (size_t)NITEM * 8192;
    p.chS = p.chOl + (size_t)NITEM * 8192;
    const size_t need = off + (size_t)NITEM * (16384 + 16384 + 8192 + 8192 + 16384) * 2;
    if (need > ws_size) { fprintf(stderr, "workspace too small: need %zu have %zu\n", need, ws_size); return; }
    if (hipMemsetAsync(p.bar, 0, XCD_BAR_WORDS * 4, stream) != hipSuccess) fprintf(stderr, "barrier memset failed\n");
    int lo = 0, hi = 5;
    void* args[] = {&p, &lo, &hi};
    hipError_t e = hipLaunchCooperativeKernel((const void*)mega, dim3(grid), dim3(256), args, LDS_BYTES, stream);
    if (e != hipSuccess) fprintf(stderr, "cooperative launch failed: %s (grid %d)\n", hipGetErrorString(e), grid);
}
```

```cpp
#include <hip/hip_runtime.h>
#include <hip/hip_cooperative_groups.h>
#include <cstdio>
namespace cg = cooperative_groups;

typedef unsigned short u16;
typedef short bf16x8 __attribute__((ext_vector_type(8)));
typedef float f32x16 __attribute__((ext_vector_type(16)));
typedef float f32x8 __attribute__((ext_vector_type(8)));
typedef float f32x4 __attribute__((ext_vector_type(4)));
typedef float f32x2 __attribute__((ext_vector_type(2)));
typedef unsigned u32x4 __attribute__((ext_vector_type(4)));
typedef unsigned u32x2 __attribute__((ext_vector_type(2)));
#define DI __device__ __forceinline__
#define MFMA32(a, b, c) __builtin_amdgcn_mfma_f32_32x32x16_bf16(__builtin_bit_cast(bf16x8, (a)), __builtin_bit_cast(bf16x8, (b)), (c), 0, 0, 0)
#define MFMA16(a, b, c) __builtin_amdgcn_mfma_f32_16x16x32_bf16(__builtin_bit_cast(bf16x8, (a)), __builtin_bit_cast(bf16x8, (b)), (c), 0, 0, 0)

constexpr int T_ALL = 33280, NP = 32768, NSLOT = 528, NITEM = NSLOT * 4;
constexpr int LDS_BYTES = 75776;

struct Params {
    const float *x_prompt, *x_sample, *cache_conv, *state_dn, *s5re0, *s5im0, *norm_w, *w_in, *conv_w, *A_log, *dt_bias,
        *dn_norm_w, *A_re, *A_im, *log_dt, *B_re, *B_im, *C_re, *C_im, *Dp, *glu_w, *glu_b, *w_out, *fnorm_w;
    float* out;
    u16 *Wb1, *Wb2, *Wb3, *bbm, *Cm, *xb, *p, *chP, *chQ, *chQeff, *chOl, *chS;
    float *lbt, *lb64, *gbeta, *E, *carry;
    unsigned* bar;
};

constexpr size_t O_Y = 0;
constexpr size_t O_CONV_P = (size_t)T_ALL * 1024;
constexpr size_t O_DN_P = O_CONV_P + 2 * 3 * 1536;
constexpr size_t O_RE_P = O_DN_P + 2 * 4 * 128 * 128;
constexpr size_t O_IM_P = O_RE_P + 2 * 32 * 64;
constexpr size_t O_CONV_S = O_IM_P + 2 * 32 * 64;
constexpr size_t O_DN_S = O_CONV_S + 16 * 3 * 1536;
constexpr size_t O_RE_S = O_DN_S + 16 * 4 * 128 * 128;
constexpr size_t O_IM_S = O_RE_S + 16 * 32 * 64;

DI int opaque_tid() { int t = threadIdx.x; asm volatile("" : "+v"(t)); return t; }
typedef __bf16 bf16x2_t __attribute__((ext_vector_type(2)));
DI u16 f2bf(float x) { return __builtin_bit_cast(u16, (__bf16)x); }
DI unsigned pk2(float a, float b) { bf16x2_t v; v[0] = (__bf16)a; v[1] = (__bf16)b; return __builtin_bit_cast(unsigned, v); }
DI float bf2f(u16 b) { return __uint_as_float(((unsigned)b) << 16); }
DI float bflo(unsigned v) { return __uint_as_float(v << 16); }
DI float bfhi(unsigned v) { return __uint_as_float(v & 0xffff0000u); }
DI int crow(int r, int hh) { return (r & 3) + 8 * (r >> 2) + 4 * hh; }
DI float silu_f(float x) { return x * __builtin_amdgcn_rcpf(1.f + __expf(-x)); }
DI float sigmoid_f(float x) { return 1.f / (1.f + __expf(-x)); }
DI float gelu_f(float x) { const float z = 0.7978845608028654f * (x + 0.044715f * x * x * x); return x / (1.f + __expf(-2.f * z)); }
DI void slot_info(int slot, int& row0, int& L) { if (slot < 512) { row0 = slot * 64; L = 64; } else { row0 = NP + (slot - 512) * 32; L = 32; } }
DI f32x16 zero16() { f32x16 z; for (int i = 0; i < 16; ++i) z[i] = 0.f; return z; }

template <int BM, class Epi>
DI void gemm_tile(const u16* __restrict__ A, int lda, const u16* __restrict__ Bt, int ldb, int K, char* smem, Epi& epi) {
    constexpr int LDT = 72;
    u16* As = (u16*)smem;
    u16* Bs = As + 2 * BM * LDT;
    constexpr int ACH = BM * 8 / 256, BCH = 4, NT = (BM == 128) ? 2 : 1;
    const int tid = opaque_tid(), lane = tid & 63, w = tid >> 6, l31 = lane & 31, hh = lane >> 5;
    const int wrow = (BM == 128) ? (w >> 1) * 64 : 0, wcol = (BM == 128) ? (w & 1) * 64 : w * 32;
    u32x4 ra[2][ACH], rb[2][BCH];
    f32x16 acc[2][NT];
#pragma unroll
    for (int m = 0; m < 2; ++m)
#pragma unroll
        for (int n = 0; n < NT; ++n) acc[m][n] = zero16();
    const int nk = K >> 6;
#define GLOAD(st, kt) do { \
        _Pragma("unroll") for (int i = 0; i < ACH; ++i) { const int id = tid + i * 256, r = id >> 3, c = id & 7; ra[st][i] = *(const u32x4*)(A + (size_t)r * lda + (kt) * 64 + c * 8); } \
        _Pragma("unroll") for (int i = 0; i < BCH; ++i) { const int id = tid + i * 256, r = id >> 3, c = id & 7; rb[st][i] = *(const u32x4*)(Bt + (size_t)r * ldb + (kt) * 64 + c * 8); } } while (0)
#define SSTORE(st, buf) do { \
        _Pragma("unroll") for (int i = 0; i < ACH; ++i) { const int id = tid + i * 256, r = id >> 3, c = id & 7; *(u32x4*)(As + (buf) * BM * LDT + r * LDT + c * 8) = ra[st][i]; } \
        _Pragma("unroll") for (int i = 0; i < BCH; ++i) { const int id = tid + i * 256, r = id >> 3, c = id & 7; *(u32x4*)(Bs + (buf) * 128 * LDT + r * LDT + c * 8) = rb[st][i]; } } while (0)
#define COMPUTE(buf) do { \
        const u16* as = As + (buf) * BM * LDT; const u16* bs = Bs + (buf) * 128 * LDT; \
        _Pragma("unroll") for (int s = 0; s < 4; ++s) { \
            u32x4 a[2], b[NT]; \
            _Pragma("unroll") for (int m = 0; m < 2; ++m) a[m] = *(const u32x4*)(as + (wrow + 32 * m + l31) * LDT + 16 * s + 8 * hh); \
            _Pragma("unroll") for (int n = 0; n < NT; ++n) b[n] = *(const u32x4*)(bs + (wcol + 32 * n + l31) * LDT + 16 * s + 8 * hh); \
            _Pragma("unroll") for (int m = 0; m < 2; ++m) _Pragma("unroll") for (int n = 0; n < NT; ++n) acc[m][n] = MFMA32(a[m], b[n], acc[m][n]); } } while (0)
#define LBAR() asm volatile("s_waitcnt lgkmcnt(0)\n\ts_barrier" ::: "memory")
    GLOAD(0, 0); SSTORE(0, 0);
    GLOAD(1, 1); GLOAD(0, 2);
    LBAR();
    for (int kt = 0; kt < nk; kt += 2) {
        COMPUTE(0);
        SSTORE(1, 1);
        if (kt + 3 < nk) GLOAD(1, kt + 3);
        LBAR();
        COMPUTE(1);
        if (kt + 2 < nk) { SSTORE(0, 0); if (kt + 4 < nk) GLOAD(0, kt + 4); }
        LBAR();
    }
#undef GLOAD
#undef SSTORE
#undef COMPUTE
#undef LBAR
#pragma unroll
    for (int m = 0; m < 2; ++m)
#pragma unroll
        for (int n = 0; n < NT; ++n) epi(wrow + 32 * m, wcol + 32 * n + l31, hh, acc[m][n]);
}


template <class Epi>
DI void gemm_tile_wide(const u16* __restrict__ A, int lda, const u16* __restrict__ Bt, int ldb, int K, char* smem, Epi& epi) {
    constexpr int LDT = 72;
    u16* As = (u16*)smem;
    u16* Bs = As + 128 * LDT;
    const int tid = opaque_tid(), lane = tid & 63, w = tid >> 6, l31 = lane & 31, hh = lane >> 5;
    const int wrow = (w >> 1) * 64, wcol = (w & 1) * 128;
    u32x4 ra[4], rb[8];
    f32x16 acc[2][4];
#pragma unroll
    for (int m = 0; m < 2; ++m)
#pragma unroll
        for (int n = 0; n < 4; ++n) acc[m][n] = zero16();
    const int nk = K >> 6;
#define WGLOAD(kt) do { \
        _Pragma("unroll") for (int i = 0; i < 4; ++i) { const int id = tid + i * 256, r = id >> 3, c = id & 7; ra[i] = *(const u32x4*)(A + (size_t)r * lda + (kt) * 64 + c * 8); } \
        _Pragma("unroll") for (int i = 0; i < 8; ++i) { const int id = tid + i * 256, r = id >> 3, c = id & 7; rb[i] = *(const u32x4*)(Bt + (size_t)r * ldb + (kt) * 64 + c * 8); } } while (0)
#define WSSTORE() do { \
        _Pragma("unroll") for (int i = 0; i < 4; ++i) { const int id = tid + i * 256, r = id >> 3, c = id & 7; *(u32x4*)(As + r * LDT + c * 8) = ra[i]; } \
        _Pragma("unroll") for (int i = 0; i < 8; ++i) { const int id = tid + i * 256, r = id >> 3, c = id & 7; *(u32x4*)(Bs + r * LDT + c * 8) = rb[i]; } } while (0)
#define WLBAR() asm volatile("s_waitcnt lgkmcnt(0)\n\ts_barrier" ::: "memory")
    WGLOAD(0); WSSTORE(); WLBAR();
    for (int kt = 0; kt < nk; ++kt) {
        if (kt + 1 < nk) WGLOAD(kt + 1);
#pragma unroll
        for (int s = 0; s < 4; ++s) {
            u32x4 a[2], b[4];
#pragma unroll
            for (int m = 0; m < 2; ++m) a[m] = *(const u32x4*)(As + (wrow + 32 * m + l31) * LDT + 16 * s + 8 * hh);
#pragma unroll
            for (int n = 0; n < 4; ++n) b[n] = *(const u32x4*)(Bs + (wcol + 32 * n + l31) * LDT + 16 * s + 8 * hh);
#pragma unroll
            for (int m = 0; m < 2; ++m)
#pragma unroll
                for (int n = 0; n < 4; ++n) acc[m][n] = MFMA32(a[m], b[n], acc[m][n]);
        }
        WLBAR();
        if (kt + 1 < nk) WSSTORE();
        WLBAR();
    }
#undef WGLOAD
#undef WSSTORE
#undef WLBAR
#pragma unroll
    for (int m = 0; m < 2; ++m)
#pragma unroll
        for (int n = 0; n < 4; ++n) epi(wrow + 32 * m, wcol + 32 * n + l31, hh, acc[m][n]);
}

DI void ph0_transpose(const Params& P, int item, float* tile) {
    const int tid = opaque_tid();
    const float* src; const float* scale = nullptr; u16* dst; int lds, ldd, n0, k0, csrc;
    if (item < 768) { const int nt = item >> 4, kt = item & 15; src = P.w_in; lds = 3080; n0 = nt * 64; csrc = n0 < 1536 ? n0 : n0 + 8; k0 = kt * 64; scale = P.norm_w; dst = P.Wb1; ldd = 1024; }
    else if (item < 1024) { const int j = item - 768, nt = j >> 4, kt = j & 15; src = P.w_out; lds = 1024; n0 = nt * 64; csrc = n0; k0 = kt * 64; dst = P.Wb2; ldd = 1024; }
    else { const int j = item - 1024, nt = j >> 3, kt = j & 7; src = P.glu_w; lds = 512; n0 = nt * 64; csrc = n0; k0 = kt * 64; dst = P.Wb3; ldd = 512; }
#pragma unroll 4
    for (int r = 0; r < 16; ++r) { const int kk = r * 4 + (tid >> 6), nn = tid & 63; float v = src[(size_t)(k0 + kk) * lds + csrc + nn]; if (scale) v *= scale[k0 + kk]; tile[kk * 65 + nn] = v; }
    __syncthreads();
#pragma unroll 4
    for (int r = 0; r < 16; ++r) { const int nn = r * 4 + (tid >> 6), kk = tid & 63; dst[(size_t)(n0 + nn) * ldd + k0 + kk] = f2bf(tile[kk * 65 + nn]); }
    __syncthreads();
}

DI void ph0_s5const(const Params& P, int idx) {
    const int g = idx >> 6, n = idx & 63;
    const float lam_re = fminf(P.A_re[idx], -1e-4f), lam_im = P.A_im[idx], dt = expf(P.log_dt[g]);
    const float ldr = lam_re * dt, ldi = lam_im * dt, mag = expf(ldr);
    const float lbr = mag * cosf(ldi), lbi = mag * sinf(ldi);
    const float den = lam_re * lam_re + lam_im * lam_im;
    const float f_re = ((lbr - 1.f) * lam_re + lbi * lam_im) / den, f_im = (lbi * lam_re - (lbr - 1.f) * lam_im) / den;
    P.lbt[idx * 2] = lbr; P.lbt[idx * 2 + 1] = lbi;
    float pr = lbr, pi = lbi;
#pragma unroll
    for (int i = 0; i < 6; ++i) { const float nr = pr * pr - pi * pi, ni = 2.f * pr * pi; pr = nr; pi = ni; }
    P.lb64[idx * 2] = pr; P.lb64[idx * 2 + 1] = pi;
#pragma unroll
    for (int c = 0; c < 16; ++c) {
        const float Br = P.B_re[idx * 16 + c], Bi = P.B_im[idx * 16 + c];
        P.bbm[(g * 128 + n) * 16 + c] = f2bf(f_re * Br - f_im * Bi);
        P.bbm[(g * 128 + 64 + n) * 16 + c] = f2bf(f_re * Bi + f_im * Br);
        P.Cm[(g * 16 + c) * 128 + 2 * n] = f2bf(P.C_re[(g * 16 + c) * 64 + n]);
        P.Cm[(g * 16 + c) * 128 + 2 * n + 1] = f2bf(-P.C_im[(g * 16 + c) * 64 + n]);
    }
}

DI float wave_sum(float v) {
#pragma unroll
    for (int d = 1; d < 64; d <<= 1) v += __shfl_xor(v, d);
    return v;
}

DI void ph0_rows(const Params& P, float* Wl) {
    const int tid = opaque_tid(), lane = tid & 63, w = tid >> 6;
#pragma unroll 8
    for (int i = tid; i < 8192; i += 256) { const int k = i >> 3, j = i & 7; Wl[i] = P.w_in[(size_t)k * 3080 + 1536 + j] * P.norm_w[k]; }
    __syncthreads();
    for (int row0 = (blockIdx.x * 4 + w) * 4; row0 < T_ALL; row0 += gridDim.x * 16) {
        float xv[4][16], d[4][8], ss[4];
#pragma unroll
        for (int rr = 0; rr < 4; ++rr) {
            const int row = row0 + rr;
            const float* xr = row < NP ? P.x_prompt + (size_t)row * 1024 : P.x_sample + (size_t)(row - NP) * 1024;
#pragma unroll
            for (int q = 0; q < 16; ++q) xv[rr][q] = xr[q * 64 + lane];
            ss[rr] = 0.f;
#pragma unroll
            for (int j = 0; j < 8; ++j) d[rr][j] = 0.f;
        }
#pragma unroll
        for (int q = 0; q < 16; ++q) {
            const f32x4 w0 = *(const f32x4*)(Wl + (q * 64 + lane) * 8), w1 = *(const f32x4*)(Wl + (q * 64 + lane) * 8 + 4);
#pragma unroll
            for (int rr = 0; rr < 4; ++rr) {
                const float x = xv[rr][q]; ss[rr] += x * x;
#pragma unroll
                for (int j = 0; j < 4; ++j) { d[rr][j] += x * w0[j]; d[rr][4 + j] += x * w1[j]; }
            }
        }
#pragma unroll
        for (int sft = 1; sft < 64; sft <<= 1) {
#pragma unroll
            for (int rr = 0; rr < 4; ++rr) {
                ss[rr] += __shfl_xor(ss[rr], sft);
#pragma unroll
                for (int j = 0; j < 8; ++j) d[rr][j] += __shfl_xor(d[rr][j], sft);
            }
        }
#pragma unroll
        for (int rr = 0; rr < 4; ++rr) {
            const int row = row0 + rr;
            const float rstd = rsqrtf(ss[rr] * (1.f / 1024.f) + 1e-6f);
#pragma unroll
            for (int q = 0; q < 16; ++q) P.xb[(size_t)row * 1024 + q * 64 + lane] = f2bf(xv[rr][q] * rstd);
            if (lane < 8) {
                float y = d[rr][0];
#pragma unroll
                for (int j = 1; j < 8; ++j) y = (lane == j) ? d[rr][j] : y;
                y *= rstd;
                float o;
                if (lane < 4) { const float a = y + P.dt_bias[lane]; const float sp = fmaxf(a, 0.f) + log1pf(expf(-fabsf(a))); o = -expf(P.A_log[lane]) * sp; }
                else o = 1.f / (1.f + expf(-y));
                P.gbeta[(size_t)row * 8 + lane] = o;
            }
        }
    }
}

DI f32x8 load8(const Params& P, bool first, bool sample, int sb, int row0, int tt, int col) {
    f32x8 o;
    if (tt >= 0 || !first) {
        const u32x4 v = *(const u32x4*)(P.p + (size_t)(row0 + tt) * 3072 + col);
#pragma unroll
        for (int i = 0; i < 4; ++i) { o[2 * i] = bflo(v[i]); o[2 * i + 1] = bfhi(v[i]); }
    } else if (sample) {
        const float* c = P.cache_conv + (size_t)(sb * 3 + 3 + tt) * 1536 + col;
        const f32x4 a = *(const f32x4*)c, b = *(const f32x4*)(c + 4);
#pragma unroll
        for (int i = 0; i < 4; ++i) { o[i] = a[i]; o[4 + i] = b[i]; }
    } else {
#pragma unroll
        for (int i = 0; i < 8; ++i) o[i] = 0.f;
    }
    return o;
}
DI float load1(const Params& P, bool first, bool sample, int sb, int row0, int tt, int col) {
    if (tt >= 0 || !first) return bf2f(P.p[(size_t)(row0 + tt) * 3072 + col]);
    if (sample) return P.cache_conv[(size_t)(sb * 3 + 3 + tt) * 1536 + col];
    return 0.f;
}
DI u32x4 ld_pair(const u16* ptr) { const u32x2 lo = *(const u32x2*)ptr, hi = *(const u32x2*)(ptr + 8); u32x4 r; r[0] = lo[0]; r[1] = lo[1]; r[2] = hi[0]; r[3] = hi[1]; return r; }

DI f32x8 load8p(const Params& P, int row0, int tt, int col) {
    f32x8 o; const u32x4 v = *(const u32x4*)(P.p + (size_t)(row0 + tt) * 3072 + col);
#pragma unroll
    for (int i = 0; i < 4; ++i) { o[2 * i] = bflo(v[i]); o[2 * i + 1] = bfhi(v[i]); }
    return o;
}
template <bool FAST>
DI void d1_conv_qk(const Params& P, bool sample, int sb, int row0, int L, int h, int tid, u16* Qs, u16* Ks, u16* Kt) {
    const int c8 = tid & 15;
#pragma unroll
    for (int X = 0; X < 2; ++X) {
        const int col = X * 512 + h * 128 + c8 * 8;
        f32x4 cw[4][2];
#pragma unroll
        for (int tap = 0; tap < 4; ++tap) { cw[tap][0] = *(const f32x4*)(P.conv_w + tap * 1536 + col); cw[tap][1] = *(const f32x4*)(P.conv_w + tap * 1536 + col + 4); }
        u32x4 raw[4][4];
        if (FAST) {
#pragma unroll
            for (int pass = 0; pass < 4; ++pass)
#pragma unroll
                for (int tap = 0; tap < 4; ++tap) raw[pass][tap] = *(const u32x4*)(P.p + (size_t)(row0 + ((pass * 256 + tid) >> 4) - 3 + tap) * 3072 + col);
        }
#pragma unroll
        for (int pass = 0; pass < 4; ++pass) {
            const int j = (pass * 256 + tid) >> 4;
            f32x8 acc; for (int e = 0; e < 8; ++e) acc[e] = 0.f;
            {
                u32x4 pv[4]; f32x4 ca[4], cb[4];
                if (!FAST) {
#pragma unroll
                    for (int tap = 0; tap < 4; ++tap) {
                        const int tt = j - 3 + tap;
                        pv[tap] = *(const u32x4*)(P.p + (size_t)(row0 + (tt > 0 ? tt : 0)) * 3072 + col);
                        const int cr = 3 + tt < 0 ? 0 : (3 + tt > 2 ? 2 : 3 + tt);
                        const float* cp = P.cache_conv + (size_t)((sample ? sb : 0) * 3 + cr) * 1536 + col;
                        ca[tap] = *(const f32x4*)cp; cb[tap] = *(const f32x4*)(cp + 4);
                    }
                }
#pragma unroll
                for (int tap = 0; tap < 4; ++tap) {
                    f32x8 in;
                    if (FAST) {
#pragma unroll
                        for (int i = 0; i < 4; ++i) { in[2 * i] = bflo(raw[pass][tap][i]); in[2 * i + 1] = bfhi(raw[pass][tap][i]); }
                    } else {
                        const bool hist = (j - 3 + tap) >= 0;
#pragma unroll
                        for (int i = 0; i < 4; ++i) {
                            const float c0 = i < 2 ? ca[tap][2 * i] : cb[tap][2 * i - 4], c1 = i < 2 ? ca[tap][2 * i + 1] : cb[tap][2 * i - 3];
                            in[2 * i] = hist ? bflo(pv[tap][i]) : (sample ? c0 : 0.f); in[2 * i + 1] = hist ? bfhi(pv[tap][i]) : (sample ? c1 : 0.f);
                        }
                    }
#pragma unroll
                    for (int e = 0; e < 4; ++e) { acc[e] += in[e] * cw[tap][0][e]; acc[4 + e] += in[4 + e] * cw[tap][1][e]; }
                }
#pragma unroll
                for (int e = 0; e < 8; ++e) acc[e] = (FAST || j < L) ? silu_f(acc[e]) : 0.f;
            }
            float ss = 0.f;
#pragma unroll
            for (int e = 0; e < 8; ++e) ss += acc[e] * acc[e];
            ss += __shfl_xor(ss, 1); ss += __shfl_xor(ss, 2); ss += __shfl_xor(ss, 4); ss += __shfl_xor(ss, 8);
            const float sc = rsqrtf(ss + 1e-6f) * (X == 0 ? 0.08838834764831845f : 1.f);
            u32x4 pk;
#pragma unroll
            for (int e = 0; e < 4; ++e) pk[e] = pk2(acc[2 * e] * sc, acc[2 * e + 1] * sc);
            if (X == 0) *(u32x4*)(Qs + j * 136 + c8 * 8) = pk;
            else {
                *(u32x4*)(Ks + j * 136 + c8 * 8) = pk;
#pragma unroll
                for (int e = 0; e < 4; ++e) { Kt[(c8 * 8 + 2 * e) * 72 + j] = (u16)(pk[e] & 0xffffu); Kt[(c8 * 8 + 2 * e + 1) * 72 + j] = (u16)(pk[e] >> 16); }
            }
        }
    }
}

template <bool FAST>
DI void d1_conv_v(const Params& P, bool sample, int sb, int row0, int L, int h, int tid, u32x4 (&vpk)[4]) {
    const bool first = true;
#pragma unroll
    for (int pass = 0; pass < 4; ++pass) {
        const int it = pass * 256 + tid, e = it & 127, j0 = (it >> 7) * 8;
        const int col = 1024 + h * 128 + e;
        float in[11];
#pragma unroll
        for (int r = 0; r < 11; ++r) { const int tt = j0 - 3 + r; if (FAST) in[r] = bf2f(P.p[(size_t)(row0 + tt) * 3072 + col]);
            else {
                const float pvv = bf2f(P.p[(size_t)(row0 + (tt > 0 ? tt : 0)) * 3072 + col]);
                const int cr = 3 + tt < 0 ? 0 : (3 + tt > 2 ? 2 : 3 + tt);
                const float cv = P.cache_conv[(size_t)((sample ? sb : 0) * 3 + cr) * 1536 + col];
                in[r] = tt >= 0 ? pvv : (sample ? cv : 0.f);
            } }
        float cw[4];
#pragma unroll
        for (int tap = 0; tap < 4; ++tap) cw[tap] = P.conv_w[tap * 1536 + col];
        float o[8];
#pragma unroll
        for (int jj = 0; jj < 8; ++jj) {
            float s = 0.f;
#pragma unroll
            for (int tap = 0; tap < 4; ++tap) s += in[jj + tap] * cw[tap];
            o[jj] = (FAST || j0 + jj < L) ? silu_f(s) : 0.f;
        }
        u32x4 pk;
#pragma unroll
        for (int q = 0; q < 4; ++q) pk[q] = pk2(o[2 * q], o[2 * q + 1]);
        vpk[pass] = pk;
    }
}

DI void d1_item(const Params& P, int item, char* smem) {
    const int tid = opaque_tid(), lane = tid & 63, w = tid >> 6, l31 = lane & 31, hh = lane >> 5;
    const int slot = item >> 2, h = item & 3;
    int row0, L; slot_info(slot, row0, L);
    const bool sample = slot >= 512; const int sb = slot - 512;
    const bool first = sample || ((slot & 255) == 0);
    u16* Qs = (u16*)smem;
    u16* Kt = Qs + 64 * 136;
    u16* R1 = Kt + 128 * 72;
    u16* R2 = R1 + 9216;
    float* sm = (float*)(R2 + 9216);
    float *gcs = sm, *betas = sm + 64, *egc = sm + 128, *sdec = sm + 192;
    u16* Ks = R1; float* Af = (float*)R2;

    if (w == 0) {
        float g = 0.f, be = 0.f;
        if (lane < L) { g = P.gbeta[(size_t)(row0 + lane) * 8 + h]; be = P.gbeta[(size_t)(row0 + lane) * 8 + 4 + h]; }
        float c = g;
#pragma unroll
        for (int d = 1; d < 64; d <<= 1) { const float t = __shfl_up(c, d); if (lane >= d) c += t; }
        const float gl = __shfl(c, 63);
        gcs[lane] = c; betas[lane] = be; egc[lane] = expf(c); sdec[lane] = expf(gl - c);
        if (lane == 0) sm[256] = expf(gl);
    }
    if (!first) d1_conv_qk<true>(P, sample, sb, row0, L, h, tid, Qs, Ks, Kt); else d1_conv_qk<false>(P, sample, sb, row0, L, h, tid, Qs, Ks, Kt);
    __syncthreads();
    unsigned atp[2][8];
    {
        const int mt = w & 1; const u16* Asrc = (w < 2) ? Ks : Qs;
        f32x16 accm[2]; accm[0] = zero16(); accm[1] = zero16();
#pragma unroll 2
        for (int s = 0; s < 8; ++s) {
            const u32x4 a = *(const u32x4*)(Asrc + (32 * mt + l31) * 136 + 16 * s + 8 * hh);
            const u32x4 b0 = *(const u32x4*)(Ks + l31 * 136 + 16 * s + 8 * hh), b1 = *(const u32x4*)(Ks + (32 + l31) * 136 + 16 * s + 8 * hh);
            accm[0] = MFMA32(a, b0, accm[0]); accm[1] = MFMA32(a, b1, accm[1]);
        }
        __builtin_amdgcn_sched_barrier(0);
#pragma unroll
        for (int nt = 0; nt < 2; ++nt) {
            const int j = 32 * nt + l31;
            const float gj = gcs[j];
#pragma unroll
            for (int q = 0; q < 4; ++q) {
                const int i0 = 32 * mt + 8 * q + 4 * hh;
                const f32x4 gi = *(const f32x4*)(gcs + i0), bi = *(const f32x4*)(betas + i0);
#pragma unroll
                for (int e = 0; e < 4; ++e) {
                    const int r = 4 * q + e;
                    const float dij = (float)(i0 + e - j);
                    const float dec = __expf(fminf(gi[e] - gj, 0.f)) * fminf(fmaxf(dij + 1.f, 0.f), 1.f);
                    const float v = accm[nt][r] * dec;
                    if (w < 2) Af[(i0 + e) * 64 + j] = bi[e] * v * fminf(fmaxf(dij, 0.f), 1.f);
                    const unsigned hb = f2bf(v);
                    if (e & 1) atp[nt][r >> 1] |= hb << 16; else atp[nt][r >> 1] = hb;
                }
                __builtin_amdgcn_sched_barrier(0);
            }
        }
    }
    __syncthreads();
    u32x4 vpk[4];
    if (w != 0) { if (!first) d1_conv_v<true>(P, sample, sb, row0, L, h, tid, vpk); else d1_conv_v<false>(P, sample, sb, row0, L, h, tid, vpk); }
    if (w == 0) {
        const int bb = hh, c = l31;
        float tc[32];
        const float cf = (float)c;
        const float* Ab = Af + (32 * bb) * 64 + 32 * bb;
#pragma unroll
        for (int i = 0; i < 32; ++i) {
            float a[4] = {fmaxf(1.f - fabsf(cf - (float)i), 0.f), 0.f, 0.f, 0.f};
#pragma unroll
            for (int jq = 0; jq < (i + 3) / 4; ++jq) {
                const f32x4 a4 = *(const f32x4*)(Ab + i * 64 + 4 * jq);
#pragma unroll
                for (int e = 0; e < 4; ++e) if (4 * jq + e < i) a[e] -= a4[e] * tc[4 * jq + e];
            }
            tc[i] = (a[0] + a[1]) + (a[2] + a[3]);
        }
        u16* T11t = R1;
        u16* A21b = R1 + 32 * 40;
        u16* T22b = R1 + 64 * 40;
        if (bb == 0) {
#pragma unroll
            for (int q = 0; q < 4; ++q) { u32x4 pk; for (int e = 0; e < 4; ++e) pk[e] = pk2(tc[8 * q + 2 * e], tc[8 * q + 2 * e + 1]); *(u32x4*)(T11t + c * 40 + 8 * q) = pk; }
        } else {
#pragma unroll
            for (int i = 0; i < 32; ++i) T22b[i * 40 + c] = f2bf(tc[i]);
        }
        {
            const float* src = Af + (32 + l31) * 64 + 16 * hh;
#pragma unroll
            for (int q = 0; q < 2; ++q) { const f32x4 v0 = *(const f32x4*)(src + 8 * q), v1 = *(const f32x4*)(src + 8 * q + 4); u32x4 pk; pk[0] = pk2(v0[0], v0[1]); pk[1] = pk2(v0[2], v0[3]); pk[2] = pk2(v1[0], v1[1]); pk[3] = pk2(v1[2], v1[3]); *(u32x4*)(A21b + l31 * 40 + 16 * hh + 8 * q) = pk; }
        }
        asm volatile("s_waitcnt lgkmcnt(0)" ::: "memory");
        f32x16 X = zero16();
#pragma unroll
        for (int s2 = 0; s2 < 2; ++s2) { const u32x4 a = *(const u32x4*)(A21b + l31 * 40 + 16 * s2 + 8 * hh), b = *(const u32x4*)(T11t + l31 * 40 + 16 * s2 + 8 * hh); X = MFMA32(a, b, X); }
        f32x16 Y = zero16();
#pragma unroll
        for (int s2 = 0; s2 < 2; ++s2) {
            u32x4 xb; for (int q = 0; q < 4; ++q) xb[q] = pk2(X[8 * s2 + 2 * q], X[8 * s2 + 2 * q + 1]);
            const u32x4 a = ld_pair(T22b + l31 * 40 + 16 * s2 + 4 * hh);
            Y = MFMA32(a, xb, Y);
        }
        asm volatile("s_waitcnt lgkmcnt(0)" ::: "memory");
        u16* T1 = R2; u16* T2 = R2 + 64 * 72;
        {
            const int col = 32 * bb + c;
            const float bc = betas[col], ec = bc * egc[col];
#pragma unroll
            for (int i = 0; i < 32; ++i) { T1[(32 * bb + i) * 72 + col] = f2bf(tc[i] * ec); T2[(32 * bb + i) * 72 + col] = f2bf(tc[i] * bc); }
            if (bb == 1) {
#pragma unroll
                for (int i = 0; i < 32; ++i) { T1[i * 72 + col] = 0; T2[i * 72 + col] = 0; }
            }
        }
        {
            const float bc = betas[l31], ec = bc * egc[l31];
#pragma unroll
            for (int r = 0; r < 16; ++r) { const int i = 32 + crow(r, hh); T1[i * 72 + l31] = f2bf(-Y[r] * ec); T2[i * 72 + l31] = f2bf(-Y[r] * bc); }
        }
    }
    __syncthreads();
    if (w == 0) { if (!first) d1_conv_v<true>(P, sample, sb, row0, L, h, tid, vpk); else d1_conv_v<false>(P, sample, sb, row0, L, h, tid, vpk); }
#pragma unroll
    for (int pass = 0; pass < 4; ++pass) { const int it = pass * 256 + tid; *(u32x4*)(R1 + (it & 127) * 72 + (it >> 7) * 8) = vpk[pass]; }
    __syncthreads();
    f32x16 wu[2][2];
    const int cb = (w & 1) * 64;
    {
        const u16* Ts = (w < 2) ? R2 : R2 + 64 * 72;
        const u16* Bsrc = (w < 2) ? Kt : R1;
#pragma unroll
        for (int m = 0; m < 2; ++m)
#pragma unroll
            for (int n = 0; n < 2; ++n) wu[m][n] = zero16();
#pragma unroll
        for (int s = 0; s < 4; ++s) {
            u32x4 a[2], b[2];
#pragma unroll
            for (int m = 0; m < 2; ++m) a[m] = *(const u32x4*)(Ts + (32 * m + l31) * 72 + 16 * s + 8 * hh);
#pragma unroll
            for (int n = 0; n < 2; ++n) b[n] = *(const u32x4*)(Bsrc + (cb + 32 * n + l31) * 72 + 16 * s + 8 * hh);
#pragma unroll
            for (int m = 0; m < 2; ++m)
#pragma unroll
                for (int n = 0; n < 2; ++n) wu[m][n] = MFMA32(a[m], b[n], wu[m][n]);
        }
    }
    __syncthreads();
    if (w >= 2) {
        const int mt = w & 1;
#pragma unroll
        for (int nt = 0; nt < 2; ++nt)
#pragma unroll
            for (int r = 0; r < 16; ++r) R2[(32 * mt + crow(r, hh)) * 72 + 32 * nt + l31] = (u16)((r & 1) ? (atp[nt][r >> 1] >> 16) : (atp[nt][r >> 1] & 0xffffu));
    }
    __syncthreads();
    u32x4 fu[2][2][2], fs[2][2][2];
#pragma unroll
    for (int m = 0; m < 2; ++m)
#pragma unroll
        for (int n = 0; n < 2; ++n)
#pragma unroll
            for (int s2 = 0; s2 < 2; ++s2)
#pragma unroll
                for (int q = 0; q < 4; ++q) {
                    const int r = 8 * s2 + 2 * q;
                    const float v0 = wu[m][n][r], v1 = wu[m][n][r + 1];
                    const float s0 = sdec[32 * m + crow(r, hh)], s1 = sdec[32 * m + crow(r + 1, hh)];
                    fu[m][n][s2][q] = pk2(v0, v1); fs[m][n][s2][q] = pk2(v0 * s0, v1 * s1);
                }
    const u16* Att = R2;
    const size_t ib = (size_t)item;
    const float egl = sm[256];
    if (w < 2) {
#pragma unroll
        for (int nt = 0; nt < 2; ++nt)
#pragma unroll 1
            for (int dt = 0; dt < 4; ++dt) {
                f32x16 acc = zero16();
#pragma unroll
                for (int m = 0; m < 2; ++m)
#pragma unroll
                    for (int s2 = 0; s2 < 2; ++s2) { const u32x4 b = ld_pair(Kt + (32 * dt + l31) * 72 + 32 * m + 16 * s2 + 4 * hh); acc = MFMA32(fs[m][nt][s2], b, acc); }
                const int d = 32 * dt + l31;
#pragma unroll
                for (int q = 0; q < 4; ++q) {
                    const int dp0 = cb + 32 * nt + 8 * q + 4 * hh;
                    float v[4];
#pragma unroll
                    for (int i = 0; i < 4; ++i) v[i] = ((d == dp0 + i) ? egl : 0.f) - acc[4 * q + i];
                    u32x2 o; o[0] = pk2(v[0], v[1]); o[1] = pk2(v[2], v[3]);
                    *(u32x2*)(P.chP + ib * 16384 + (size_t)((((d >> 5) * 8 + (dp0 >> 4)) * 64 + ((dp0 >> 3) & 1) * 32 + (d & 31)) * 8 + (dp0 & 7))) = o;
                }
            }
#pragma unroll
        for (int nt = 0; nt < 2; ++nt)
#pragma unroll 1
            for (int it = 0; it < 2; ++it) {
                f32x16 acc = zero16();
#pragma unroll
                for (int m = 0; m < 2; ++m)
#pragma unroll
                    for (int s2 = 0; s2 < 2; ++s2) { const u32x4 b = ld_pair(Att + (32 * it + l31) * 72 + 32 * m + 16 * s2 + 4 * hh); acc = MFMA32(fu[m][nt][s2], b, acc); }
                const int i = 32 * it + l31;
                const float eg = egc[i];
#pragma unroll
                for (int q = 0; q < 4; ++q) {
                    const int dp0 = cb + 32 * nt + 8 * q + 4 * hh;
                    const u32x2 qv = *(const u32x2*)(Qs + i * 136 + dp0);
                    u32x2 o;
                    o[0] = pk2(bflo(qv[0]) * eg - acc[4 * q], bfhi(qv[0]) * eg - acc[4 * q + 1]);
                    o[1] = pk2(bflo(qv[1]) * eg - acc[4 * q + 2], bfhi(qv[1]) * eg - acc[4 * q + 3]);
                    *(u32x2*)(P.chQeff + ib * 8192 + (size_t)((((i >> 5) * 8 + (dp0 >> 4)) * 64 + ((dp0 >> 3) & 1) * 32 + (i & 31)) * 8 + (dp0 & 7))) = o;
                }
            }
    } else {
#pragma unroll 1
        for (int dt = 0; dt < 4; ++dt)
#pragma unroll
            for (int nt = 0; nt < 2; ++nt) {
                f32x16 acc = zero16();
#pragma unroll
                for (int m = 0; m < 2; ++m)
#pragma unroll
                    for (int s2 = 0; s2 < 2; ++s2) { const u32x4 a = ld_pair(Kt + (32 * dt + l31) * 72 + 32 * m + 16 * s2 + 4 * hh); acc = MFMA32(a, fs[m][nt][s2], acc); }
                const int e = cb + 32 * nt + l31;
#pragma unroll
                for (int q = 0; q < 4; ++q) {
                    const int d0 = 32 * dt + 8 * q + 4 * hh;
                    u32x2 o; o[0] = pk2(acc[4 * q], acc[4 * q + 1]); o[1] = pk2(acc[4 * q + 2], acc[4 * q + 3]);
                    *(u32x2*)(P.chQ + ib * 16384 + (size_t)(((((e >> 5) * 4 + dt) * 4 + q) * 64 + hh * 32 + (e & 31)) * 4)) = o;
                }
            }
#pragma unroll 1
        for (int it = 0; it < 2; ++it)
#pragma unroll
            for (int nt = 0; nt < 2; ++nt) {
                f32x16 acc = zero16();
#pragma unroll
                for (int m = 0; m < 2; ++m)
#pragma unroll
                    for (int s2 = 0; s2 < 2; ++s2) { const u32x4 a = ld_pair(Att + (32 * it + l31) * 72 + 32 * m + 16 * s2 + 4 * hh); acc = MFMA32(a, fu[m][nt][s2], acc); }
                const int e = cb + 32 * nt + l31;
#pragma unroll
                for (int q = 0; q < 4; ++q) {
                    const int i0 = 32 * it + 8 * q + 4 * hh;
                    u32x2 o; o[0] = pk2(acc[4 * q], acc[4 * q + 1]); o[1] = pk2(acc[4 * q + 2], acc[4 * q + 3]);
                    *(u32x2*)(P.chOl + ib * 8192 + (size_t)(((((e >> 5) * 2 + it) * 4 + q) * 64 + hh * 32 + (e & 31)) * 4)) = o;
                }
            }
    }
    __syncthreads();
}

DI void s5_wave(const Params& P, int slot, int g, int mode, u32x4* XsV) {
    unsigned* Xs = (unsigned*)XsV;
    const int lane = opaque_tid() & 63, l31 = lane & 31, hh = lane >> 5;
    int row0, L; slot_info(slot, row0, L);
    const int MT = L >> 5;
    float lr[2], li[2], l2r[2], l2i[2], l3r[2], l3i[2], l4r[2], l4i[2], Xr[2], Xi[2];
#pragma unroll
    for (int st = 0; st < 2; ++st) {
        const int n = 32 * st + l31;
        lr[st] = P.lbt[(g * 64 + n) * 2]; li[st] = P.lbt[(g * 64 + n) * 2 + 1];
        l2r[st] = lr[st] * lr[st] - li[st] * li[st]; l2i[st] = 2.f * lr[st] * li[st];
        l3r[st] = l2r[st] * lr[st] - l2i[st] * li[st]; l3i[st] = l2r[st] * li[st] + l2i[st] * lr[st];
        l4r[st] = l2r[st] * l2r[st] - l2i[st] * l2i[st]; l4i[st] = 2.f * l2r[st] * l2i[st];
        if (mode == 0) { Xr[st] = 0.f; Xi[st] = 0.f; }
        else if (slot < 512) { Xr[st] = P.carry[((size_t)(slot * 32 + g) * 64 + n) * 2]; Xi[st] = P.carry[((size_t)(slot * 32 + g) * 64 + n) * 2 + 1]; }
        else { Xr[st] = P.s5re0[((slot - 512) * 32 + g) * 64 + n]; Xi[st] = P.s5im0[((slot - 512) * 32 + g) * 64 + n]; }
    }
    u32x4 bfr[4];
#pragma unroll
    for (int nt = 0; nt < 4; ++nt) bfr[nt] = *(const u32x4*)(P.bbm + (size_t)(g * 128 + 32 * nt + l31) * 16 + 8 * hh);
#pragma unroll
    for (int m = 0; m < 2; ++m) {
        if (m < MT) {
            f32x16 bu[4];
            {
                const u32x4 a = *(const u32x4*)(P.p + (size_t)(row0 + 32 * m + l31) * 3072 + 2048 + 16 * g + 8 * hh);
#pragma unroll
                for (int nt = 0; nt < 4; ++nt) bu[nt] = MFMA32(a, bfr[nt], zero16());
            }
#pragma unroll
            for (int q = 0; q < 4; ++q)
#pragma unroll
                for (int st = 0; st < 2; ++st) {
                    float yr[4], yi[4];
                    yr[0] = bu[st][4 * q]; yi[0] = bu[st + 2][4 * q];
#pragma unroll
                    for (int r = 1; r < 4; ++r) {
                        yr[r] = lr[st] * yr[r - 1] - li[st] * yi[r - 1] + bu[st][4 * q + r];
                        yi[r] = lr[st] * yi[r - 1] + li[st] * yr[r - 1] + bu[st + 2][4 * q + r];
                    }
                    const float per = __shfl_xor(yr[3], 32), pei = __shfl_xor(yi[3], 32);
                    const float e0r = hh ? per : yr[3], e0i = hh ? pei : yi[3], e1r = hh ? yr[3] : per, e1i = hh ? yi[3] : pei;
                    const float xer = Xr[st], xei = Xi[st];
                    const float xor_ = l4r[st] * xer - l4i[st] * xei + e0r, xoi = l4r[st] * xei + l4i[st] * xer + e0i;
                    Xr[st] = l4r[st] * xor_ - l4i[st] * xoi + e1r; Xi[st] = l4r[st] * xoi + l4i[st] * xor_ + e1i;
                    if (mode) {
                        const float pr = hh ? xor_ : xer, pi = hh ? xoi : xei;
                        const int t0 = 32 * m + 8 * q + 4 * hh;
                        unsigned* xrow = Xs + t0 * 68 + 32 * st + l31;
                        xrow[0]       = pk2(yr[0] + lr[st] * pr - li[st] * pi,   yi[0] + lr[st] * pi + li[st] * pr);
                        xrow[68]      = pk2(yr[1] + l2r[st] * pr - l2i[st] * pi, yi[1] + l2r[st] * pi + l2i[st] * pr);
                        xrow[2 * 68]  = pk2(yr[2] + l3r[st] * pr - l3i[st] * pi, yi[2] + l3r[st] * pi + l3i[st] * pr);
                        xrow[3 * 68]  = pk2(yr[3] + l4r[st] * pr - l4i[st] * pi, yi[3] + l4r[st] * pi + l4i[st] * pr);
                    }
                }
        }
    }
    if (mode == 0) {
        if (hh == 0) {
#pragma unroll
            for (int st = 0; st < 2; ++st) { const int n = 32 * st + l31; P.E[((size_t)(slot * 32 + g) * 64 + n) * 2] = Xr[st]; P.E[((size_t)(slot * 32 + g) * 64 + n) * 2 + 1] = Xi[st]; }
        }
        return;
    }
    if (slot >= 512 && hh == 0) {
#pragma unroll
        for (int st = 0; st < 2; ++st) { const int n = 32 * st + l31; P.out[O_RE_S + ((slot - 512) * 32 + g) * 64 + n] = Xr[st]; P.out[O_IM_S + ((slot - 512) * 32 + g) * 64 + n] = Xi[st]; }
    }
    asm volatile("s_waitcnt lgkmcnt(0)" ::: "memory");
    const int l15 = lane & 15, lq = lane >> 4;
    u32x4 cf[4];
#pragma unroll
    for (int ks = 0; ks < 4; ++ks) cf[ks] = *(const u32x4*)(P.Cm + (size_t)(g * 16 + l15) * 128 + 32 * ks + 8 * lq);
    const float Dv = P.Dp[16 * g + l15];
    const u16* Xh = (const u16*)Xs;
#pragma unroll
    for (int m4 = 0; m4 < 4; ++m4) {
        if (m4 < 2 * MT) {
            f32x4 ya = {0.f, 0.f, 0.f, 0.f};
#pragma unroll
            for (int ks = 0; ks < 4; ++ks) { const u32x4 a = *(const u32x4*)(Xh + (16 * m4 + l15) * 136 + 32 * ks + 8 * lq); ya = MFMA16(a, cf[ks], ya); }
            u16 uv[4];
#pragma unroll
            for (int r = 0; r < 4; ++r) uv[r] = P.p[(size_t)(row0 + 16 * m4 + 4 * lq + r) * 3072 + 2048 + 16 * g + l15];
#pragma unroll
            for (int r = 0; r < 4; ++r) P.p[(size_t)(row0 + 16 * m4 + 4 * lq + r) * 3072 + 16 * g + l15] = f2bf(gelu_f(ya[r] + Dv * bf2f(uv[r])));
        }
    }
    asm volatile("s_waitcnt lgkmcnt(0)" ::: "memory");
}

DI void chain_item(const Params& P, int it, char* smem) {
    const int tid = opaque_tid(), lane = tid & 63, w = tid >> 6, l31 = lane & 31, hh = lane >> 5;
    int es, h, nsteps, slot0; float* outp; f32x16 acc;
    if (it < 32) {
        const int bh = it >> 2; es = it & 3; const int b = bh >> 2; h = bh & 3; nsteps = 256; slot0 = b * 256;
        outp = P.out + O_DN_P + (size_t)(b * 4 + h) * 16384; acc = zero16();
    } else {
        const int j = it - 32, bh = j >> 2; es = j & 3; const int b = bh >> 2; h = bh & 3; nsteps = 1; slot0 = 512 + b;
        outp = P.out + O_DN_S + (size_t)(b * 4 + h) * 16384;
        const float* s0 = P.state_dn + (size_t)(b * 4 + h) * 16384;
#pragma unroll
        for (int r = 0; r < 16; ++r) acc[r] = s0[(32 * w + crow(r, hh)) * 128 + 32 * es + l31];
    }
    u16* Sb = (u16*)smem;
    const size_t poff = (size_t)(w * 8 * 64 + lane) * 8;
    const size_t qoff = (size_t)((es * 4 + w) * 4 * 64 + lane) * 4;
    const size_t soff = (size_t)(((es * 8 + (tid & 7)) * 64 + (tid >> 3)) * 8);
    constexpr int DEPTH = 4;
    u32x4 pa[DEPTH][8]; u32x2 qm[DEPTH][4];
#pragma unroll
    for (int i = 0; i < DEPTH; ++i) {
        if (i < nsteps) {
            const size_t ib = (size_t)(slot0 + i) * 4 + h;
#pragma unroll
            for (int s = 0; s < 8; ++s) pa[i][s] = *(const u32x4*)(P.chP + ib * 16384 + poff + 512 * s);
#pragma unroll
            for (int q = 0; q < 4; ++q) qm[i][q] = *(const u32x2*)(P.chQ + ib * 16384 + qoff + 256 * q);
        } else {
#pragma unroll
            for (int s = 0; s < 8; ++s) pa[i][s] = (u32x4){0u, 0u, 0u, 0u};
#pragma unroll
            for (int q = 0; q < 4; ++q) qm[i][q] = (u32x2){0u, 0u};
        }
    }
    for (int c0 = 0; c0 < nsteps; c0 += DEPTH) {
#pragma unroll
        for (int i = 0; i < DEPTH; ++i) {
            const int c = c0 + i;
            if (c < nsteps) {
                const size_t ib = (size_t)(slot0 + c) * 4 + h;
                u16* sb = Sb + (c & 1) * 32 * 136;
#pragma unroll
                for (int q = 0; q < 4; ++q) {
                    u32x2 o; o[0] = pk2(acc[4 * q], acc[4 * q + 1]); o[1] = pk2(acc[4 * q + 2], acc[4 * q + 3]);
                    *(u32x2*)(sb + l31 * 136 + 32 * w + 8 * q + 4 * hh) = o;
                }
                asm volatile("s_waitcnt lgkmcnt(0)\n\ts_barrier" ::: "memory");
                {
                    const u32x4 s0 = *(const u32x4*)(sb + (tid >> 3) * 136 + (tid & 7) * 16), s1 = *(const u32x4*)(sb + (tid >> 3) * 136 + (tid & 7) * 16 + 8);
                    *(u32x4*)(P.chS + ib * 16384 + soff) = s0; *(u32x4*)(P.chS + ib * 16384 + soff + 32 * 8) = s1;
                }
                f32x16 an0, an1 = zero16();
#pragma unroll
                for (int q = 0; q < 4; ++q) { an0[4 * q] = bflo(qm[i][q][0]); an0[4 * q + 1] = bfhi(qm[i][q][0]); an0[4 * q + 2] = bflo(qm[i][q][1]); an0[4 * q + 3] = bfhi(qm[i][q][1]); }
#pragma unroll
                for (int s = 0; s < 8; s += 2) {
                    const u32x4 b0 = *(const u32x4*)(sb + l31 * 136 + 16 * s + 8 * hh), b1 = *(const u32x4*)(sb + l31 * 136 + 16 * s + 16 + 8 * hh);
                    an0 = MFMA32(pa[i][s], b0, an0); an1 = MFMA32(pa[i][s + 1], b1, an1);
                }
#pragma unroll
                for (int r = 0; r < 16; ++r) acc[r] = an0[r] + an1[r];
                if (c + DEPTH < nsteps) {
                    const size_t ibn = ib + 4 * DEPTH;
#pragma unroll
                    for (int s = 0; s < 8; ++s) pa[i][s] = *(const u32x4*)(P.chP + ibn * 16384 + poff + 512 * s);
#pragma unroll
                    for (int q = 0; q < 4; ++q) qm[i][q] = *(const u32x2*)(P.chQ + ibn * 16384 + qoff + 256 * q);
                }
            }
        }
    }
#pragma unroll
    for (int r = 0; r < 16; ++r) outp[(32 * w + crow(r, hh)) * 128 + 32 * es + l31] = acc[r];
    __syncthreads();
}

DI void s5_carry(const Params& P, int idx) {
    const int b = idx >> 11, gn = idx & 2047;
    const float ar = P.lb64[gn * 2], ai = P.lb64[gn * 2 + 1];
    const f32x2* __restrict__ Ep = (const f32x2*)P.E + (size_t)b * 256 * 2048 + gn;
    f32x2* __restrict__ Cp = (f32x2*)P.carry + (size_t)b * 256 * 2048 + gn;
    float xr = 0.f, xi = 0.f;
    for (int c0 = 0; c0 < 256; c0 += 16) {
        f32x2 e[16];
#pragma unroll
        for (int i = 0; i < 16; ++i) e[i] = Ep[(size_t)(c0 + i) * 2048];
#pragma unroll
        for (int i = 0; i < 16; ++i) {
            f32x2 o; o[0] = xr; o[1] = xi; Cp[(size_t)(c0 + i) * 2048] = o;
            const float nr = ar * xr - ai * xi + e[i][0], ni = ar * xi + ai * xr + e[i][1];
            xr = nr; xi = ni;
        }
    }
    P.out[O_RE_P + b * 2048 + gn] = xr; P.out[O_IM_P + b * 2048 + gn] = xi;
}

struct EpiP { u16* p; DI void operator()(int rbase, int col, int hh, const f32x16& v) const {
#pragma unroll
    for (int r = 0; r < 16; ++r) p[(size_t)(rbase + crow(r, hh)) * 3072 + col] = f2bf(v[r]); } };
struct EpiGlu { u16* prow; const float* gb; int L; int n0; DI void operator()(int rbase, int col, int hh, const f32x16& v) const {
    const int n = n0 + col; const float bias = gb[n];
#pragma unroll
    for (int r = 0; r < 16; ++r) { const int i = rbase + crow(r, hh);
        if (i < L) { u16* pr = prow + (size_t)i * 3072; const float gy = bf2f(pr[n]), z = bf2f(pr[2560 + n]); pr[1024 + n] = f2bf(gy * sigmoid_f(v[r] + bias) * silu_f(z)); } } } };
struct EpiOut { const float* x; float* y; int L; int n0; DI void operator()(int rbase, int col, int hh, const f32x16& v) const {
    const int n = n0 + col;
#pragma unroll
    for (int r = 0; r < 16; ++r) { const int i = rbase + crow(r, hh); if (i < L) y[(size_t)i * 1024 + n] = x[(size_t)i * 1024 + n] + v[r]; } } };

DI void f3_delta(const Params& P, int slot, int row0, int L, int h, int m) {
    const int tid = opaque_tid(), lane = tid & 63, l31 = lane & 31, hh = lane >> 5;
    if (32 * m >= L) return;
    const size_t ib = (size_t)slot * 4 + h;
    const u16* Qe = P.chQeff + ib * 8192; const u16* Sa = P.chS + ib * 16384; const u16* Ol = P.chOl + ib * 8192;
    f32x16 o[4];
#pragma unroll
    for (int nt = 0; nt < 4; ++nt)
#pragma unroll
        for (int q = 0; q < 4; ++q) {
            const u32x2 v = *(const u32x2*)(Ol + (size_t)((((nt * 2 + m) * 4 + q) * 64 + lane) * 4));
            o[nt][4 * q] = bflo(v[0]); o[nt][4 * q + 1] = bfhi(v[0]); o[nt][4 * q + 2] = bflo(v[1]); o[nt][4 * q + 3] = bfhi(v[1]);
        }
#pragma unroll 4
    for (int s = 0; s < 8; ++s) {
        const u32x4 a = *(const u32x4*)(Qe + (size_t)(((m * 8 + s) * 64 + lane) * 8));
        u32x4 b[4];
#pragma unroll
        for (int nt = 0; nt < 4; ++nt) b[nt] = *(const u32x4*)(Sa + (size_t)(((nt * 8 + s) * 64 + lane) * 8));
#pragma unroll
        for (int nt = 0; nt < 4; ++nt) o[nt] = MFMA32(a, b[nt], o[nt]);
    }
    float nw[4];
#pragma unroll
    for (int nt = 0; nt < 4; ++nt) nw[nt] = P.dn_norm_w[32 * nt + l31];
    u16 zv[16][4];
#pragma unroll
    for (int r = 0; r < 16; ++r) {
        const u16* pr = P.p + (size_t)(row0 + 32 * m + crow(r, hh)) * 3072 + 1536 + h * 128 + l31;
#pragma unroll
        for (int nt = 0; nt < 4; ++nt) zv[r][nt] = pr[32 * nt];
    }
#pragma unroll
    for (int r = 0; r < 16; ++r) {
        float ss = 0.f;
#pragma unroll
        for (int nt = 0; nt < 4; ++nt) ss += o[nt][r] * o[nt][r];
        ss += __shfl_xor(ss, 1); ss += __shfl_xor(ss, 2); ss += __shfl_xor(ss, 4); ss += __shfl_xor(ss, 8); ss += __shfl_xor(ss, 16);
        const float rs = rsqrtf(ss * (1.f / 128.f) + 1e-6f);
        u16* pr = P.p + (size_t)(row0 + 32 * m + crow(r, hh)) * 3072 + 512 + h * 128 + l31;
#pragma unroll
        for (int nt = 0; nt < 4; ++nt) pr[32 * nt] = f2bf(o[nt][r] * rs * nw[nt] * silu_f(bf2f(zv[r][nt])));
    }
}

DI void mixer_s5_item(const Params& P, int item, char* smem) {
    const int tid = opaque_tid(), w = tid >> 6;
    const int slot = item >> 2, qt = item & 3;
    u32x4* xs = (u32x4*)(smem + w * 17408);
    s5_wave(P, slot, 8 * qt + w, 1, xs);
    s5_wave(P, slot, 8 * qt + 4 + w, 1, xs);
}
DI void mixer_dn_item(const Params& P, int item) {
    const int tid = opaque_tid(), w = tid >> 6;
    const int slot = item >> 1, hp = item & 1;
    int row0, L; slot_info(slot, row0, L);
    f3_delta(P, slot, row0, L, 2 * hp + (w >> 1), w & 1);
}
struct EpiGluT { u16* prow; const float* gb; int n0; DI void operator()(int rbase, int col, int hh, const f32x16& v) const {
    const int n = n0 + col; const float bias = gb[n];
    u16 gyv[16], zv[16];
#pragma unroll
    for (int r = 0; r < 16; ++r) { const u16* pr = prow + (size_t)(rbase + crow(r, hh)) * 3072; gyv[r] = pr[n]; zv[r] = pr[2560 + n]; }
#pragma unroll
    for (int r = 0; r < 16; ++r) { u16* pr = prow + (size_t)(rbase + crow(r, hh)) * 3072; pr[1024 + n] = f2bf(bf2f(gyv[r]) * sigmoid_f(v[r] + bias) * silu_f(bf2f(zv[r]))); } } };
struct EpiOutT { const float* x; float* y; int n0; DI void operator()(int rbase, int col, int hh, const f32x16& v) const {
    const int n = n0 + col;
    float xv[16];
#pragma unroll
    for (int r = 0; r < 16; ++r) xv[r] = x[(size_t)(rbase + crow(r, hh)) * 1024 + n];
#pragma unroll
    for (int r = 0; r < 16; ++r) y[(size_t)(rbase + crow(r, hh)) * 1024 + n] = xv[r] + v[r]; } };
DI void norm_rows(const Params& P, int G, int B) {
    const int tid = opaque_tid(), lane = tid & 63, w = tid >> 6;
    f32x4 fw[4];
#pragma unroll
    for (int q = 0; q < 4; ++q) fw[q] = *(const f32x4*)(P.fnorm_w + q * 256 + lane * 4);
    for (int row0 = (B * 4 + w) * 2; row0 < T_ALL; row0 += G * 8) {
        f32x4 v[2][4]; float ss[2];
#pragma unroll
        for (int rr = 0; rr < 2; ++rr) {
            const float* r = P.out + O_Y + (size_t)(row0 + rr) * 1024;
#pragma unroll
            for (int q = 0; q < 4; ++q) v[rr][q] = *(const f32x4*)(r + q * 256 + lane * 4);
        }
#pragma unroll
        for (int rr = 0; rr < 2; ++rr) {
            ss[rr] = 0.f;
#pragma unroll
            for (int q = 0; q < 4; ++q) ss[rr] += v[rr][q][0] * v[rr][q][0] + v[rr][q][1] * v[rr][q][1] + v[rr][q][2] * v[rr][q][2] + v[rr][q][3] * v[rr][q][3];
        }
#pragma unroll
        for (int sft = 1; sft < 64; sft <<= 1) { ss[0] += __shfl_xor(ss[0], sft); ss[1] += __shfl_xor(ss[1], sft); }
#pragma unroll
        for (int rr = 0; rr < 2; ++rr) {
            float* r = P.out + O_Y + (size_t)(row0 + rr) * 1024;
            const float rs = rsqrtf(ss[rr] * (1.f / 1024.f) + 1e-6f);
#pragma unroll
            for (int q = 0; q < 4; ++q) { f32x4 o; for (int e = 0; e < 4; ++e) o[e] = v[rr][q][e] * rs * fw[q][e]; *(f32x4*)(r + q * 256 + lane * 4) = o; }
        }
    }
}

#define XB_TMO      128
#define XB_XCNT(j)  (256  + 64 * (j))
#define XB_XSUB(j)  (1280 + 64 * (j))
#define XB_XGEN(j)  (2304 + 64 * (j))
#define XB_TOP      3328
#define XB_TOPGEN   3392
#define XCD_BAR_WORDS 3456
#define XB_SPIN_CAP (1u << 22)
#define LAS __attribute__((address_space(3)))
DI unsigned xb_ld(unsigned* p) { return __hip_atomic_load(p, __ATOMIC_RELAXED, __HIP_MEMORY_SCOPE_AGENT); }
DI unsigned xb_add(unsigned* p, unsigned v) { return __hip_atomic_fetch_add(p, v, __ATOMIC_RELAXED, __HIP_MEMORY_SCOPE_AGENT); }
DI unsigned xb_xcc_id() { return (unsigned)__builtin_amdgcn_s_getreg((3 << 11) | 20) & 0xFu; }
#define XB_SPIN(cond, bar) do { unsigned _sp = 0; while (cond) { __builtin_amdgcn_s_sleep(1); \
    if ((++_sp & 255u) == 0u) { if (xb_ld(&(bar)[XB_TMO])) break; if (_sp > XB_SPIN_CAP) { atomicAdd(&(bar)[XB_TMO], 1u); break; } } } } while (0)
struct XcdBarrier { unsigned* bar; unsigned x; volatile LAS unsigned* st; };
DI XcdBarrier xcd_barrier_post(unsigned* bar, volatile LAS unsigned* st) {
    XcdBarrier b; b.bar = bar; b.x = xb_xcc_id(); b.st = st;
    if (threadIdx.x == 0) (void)xb_add(&bar[XB_XCNT(b.x)], 1u);
    return b;
}
DI void xcd_barrier_complete(unsigned* bar, unsigned x, unsigned& nloc, unsigned& nx) {
    const unsigned G = gridDim.x * gridDim.y * gridDim.z;
    unsigned sum, cnt, mine, sp = 0u;
    for (;;) {
        sum = 0u; cnt = 0u; mine = 0u;
#pragma unroll
        for (unsigned j = 0; j < 16; ++j) { const unsigned c = xb_ld(&bar[XB_XCNT(j)]); sum += c; cnt += (c > 0u) ? 1u : 0u; mine = (j == x) ? c : mine; }
        if (sum == G) break;
        __builtin_amdgcn_s_sleep(1);
        if ((++sp & 255u) == 0u) { if (xb_ld(&bar[XB_TMO])) break; if (sp > XB_SPIN_CAP) { atomicAdd(&bar[XB_TMO], 1u); break; } }
    }
    nloc = mine > 0u ? mine : 1u; nx = cnt > 0u ? cnt : 1u;
}
DI void xcd_barrier(const XcdBarrier& b) {
    asm volatile("s_waitcnt vmcnt(0)" ::: "memory");
    __syncthreads();
    if (threadIdx.x == 0) {
        unsigned* bar = b.bar;
        __builtin_amdgcn_s_waitcnt(0);
        unsigned nloc = b.st[0], nx = b.st[1];
        if (nloc == 0u) { xcd_barrier_complete(bar, b.x, nloc, nx); b.st[0] = nloc; b.st[1] = nx; }
        const unsigned old = xb_add(&bar[XB_XSUB(b.x)], 1u);
        const unsigned gen = old / nloc;
        if (old + 1u == (gen + 1u) * nloc) {
            __builtin_amdgcn_fence(__ATOMIC_RELEASE, "agent");
            asm volatile("s_waitcnt vmcnt(0)" ::: "memory");
            const unsigned og = xb_add(&bar[XB_TOP], 1u);
            const unsigned tg = og / nx;
            if (og + 1u == (tg + 1u) * nx) xb_add(&bar[XB_TOPGEN], 1u);
            else XB_SPIN(xb_ld(&bar[XB_TOPGEN]) == tg, bar);
            __builtin_amdgcn_fence(__ATOMIC_ACQUIRE, "agent");
            xb_add(&bar[XB_XGEN(b.x)], 1u);
            asm volatile("s_waitcnt vmcnt(0)" ::: "memory");
        } else {
            XB_SPIN(xb_ld(&bar[XB_XGEN(b.x)]) == gen, bar);
            __builtin_amdgcn_fence(__ATOMIC_ACQUIRE, "agent");
            asm volatile("s_waitcnt vmcnt(0)" ::: "memory");
        }
    }
    __syncthreads();
}

#ifndef ONLY_PH
#define ONLY_PH -1
#endif
#define PH_ON(x) (ONLY_PH < 0 || ONLY_PH == (x))
__global__ void __launch_bounds__(256, 2) mega(Params P, int ph_lo, int ph_hi) {
    extern __shared__ __attribute__((aligned(16))) char smem[];
    const int G = gridDim.x, B = blockIdx.x;
    const bool multi = (ph_hi - ph_lo) > 1;
    __shared__ uint4 xb_words;
    if (threadIdx.x == 0) xb_words = make_uint4(0u, 0u, 0u, 0u);
    __syncthreads();
    XcdBarrier xb = xcd_barrier_post(P.bar, (volatile LAS unsigned*)&xb_words);
    if (ph_hi > 1000) cg::this_grid().sync();
    if (ph_lo <= 0 && ph_hi > 0 && PH_ON(0)) {
        const int tid = opaque_tid();
        for (int it = B; it < 1088 + 8; it += G) {
            if (it < 1088) ph0_transpose(P, it, (float*)smem);
            else ph0_s5const(P, (it - 1088) * 256 + tid);
        }
        __syncthreads();
        ph0_rows(P, (float*)smem);
    }
    if (multi) xcd_barrier(xb);
    if (ph_lo <= 1 && ph_hi > 1 && PH_ON(1)) {
        const int nwide = (260 * 12 / G) * G;
        for (int t = B; t < nwide; t += G) {
            const int mt = t / 12, nt = t % 12;
            EpiP epi{P.p + (size_t)mt * 128 * 3072 + nt * 256};
            gemm_tile_wide(P.xb + (size_t)mt * 128 * 1024, 1024, P.Wb1 + (size_t)nt * 256 * 1024, 1024, 1024, smem, epi);
        }
        for (int u = B; u < (260 * 12 - nwide) * 4; u += G) {
            const int t = nwide + (u >> 2), mt = t / 12, nt = (t % 12) * 2 + ((u >> 1) & 1), r0 = mt * 128 + (u & 1) * 64;
            EpiP epi{P.p + (size_t)r0 * 3072 + nt * 128};
            gemm_tile<64>(P.xb + (size_t)r0 * 1024, 1024, P.Wb1 + (size_t)nt * 128 * 1024, 1024, 1024, smem, epi);
        }
    }
    if (multi) xcd_barrier(xb);
    if (ph_lo <= 2 && ph_hi > 2 && PH_ON(2)) {
        if (G >= 304 + 32) {
            for (int it = B; it < 2048; it += G) d1_item(P, it, smem);
        } else {
            for (int it = B; it < NITEM; it += G) d1_item(P, it < 64 ? 2048 + it : it - 64, smem);
            const int w = opaque_tid() >> 6;
            for (int j = B; j < 4096; j += G) s5_wave(P, j >> 3, (j & 7) * 4 + w, 0, nullptr);
        }
        const int tid = opaque_tid();
        for (int i = B * 256 + tid; i < 18 * 3 * 1536; i += G * 256) {
            const int sq = i / 4608, rem = i % 4608, r = rem / 1536, c = rem % 1536;
            const int row = sq < 2 ? sq * 16384 + 16381 + r : NP + (sq - 2) * 32 + 29 + r;
            const float v = bf2f(P.p[(size_t)row * 3072 + c]);
            if (sq < 2) P.out[O_CONV_P + i] = v; else P.out[O_CONV_S + (i - 2 * 4608)] = v;
        }
    }
    if (multi) xcd_barrier(xb);
    if (ph_lo <= 3 && ph_hi > 3 && PH_ON(3)) {
        if (G >= 304 + 32) {
            if (B >= 32) {
                const int w = opaque_tid() >> 6;
                for (int j = B - 32; j < 4096; j += G - 32) s5_wave(P, j >> 3, (j & 7) * 4 + w, 0, nullptr);
                asm volatile("s_waitcnt vmcnt(0)" ::: "memory");
                __syncthreads();
                if (threadIdx.x == 0) { __builtin_amdgcn_fence(__ATOMIC_RELEASE, "agent"); asm volatile("s_waitcnt vmcnt(0)" ::: "memory"); xb_add(&P.bar[65], 1u); }
            }
            if (B < 32) chain_item(P, B, smem);
            else if (B < 288) { d1_item(P, 2048 + ((B - 32) >> 2), smem); chain_item(P, B, smem); }
            else if (B < 304) {
                if (threadIdx.x == 0) { unsigned sp = 0; while (xb_ld(&P.bar[65]) < (unsigned)(G - 32) && ++sp < (1u << 24)) __builtin_amdgcn_s_sleep(4); }
                __syncthreads();
                __builtin_amdgcn_fence(__ATOMIC_ACQUIRE, "agent");
                asm volatile("s_waitcnt vmcnt(0)" ::: "memory");
                __syncthreads();
                s5_carry(P, (B - 288) * 256 + opaque_tid());
                asm volatile("s_waitcnt vmcnt(0)" ::: "memory");
                __syncthreads();
                if (threadIdx.x == 0) { __builtin_amdgcn_fence(__ATOMIC_RELEASE, "agent"); asm volatile("s_waitcnt vmcnt(0)" ::: "memory"); xb_add(&P.bar[64], 1u); }
            }
            if (B >= 32 && (B < 288 || B >= 304)) {
                const int wi = B < 288 ? B - 32 : B - 304 + 256, nw = G - 48;
                if (threadIdx.x == 0) { unsigned sp = 0; while (xb_ld(&P.bar[64]) < 16u && ++sp < (1u << 24)) __builtin_amdgcn_s_sleep(4); }
                __syncthreads();
                __builtin_amdgcn_fence(__ATOMIC_ACQUIRE, "agent");
                asm volatile("s_waitcnt vmcnt(0)" ::: "memory");
                __syncthreads();
                for (int it = wi; it < NSLOT * 4; it += nw) mixer_s5_item(P, it, smem);
            }
        } else {
            for (int it = B; it < 288 + 16; it += G) {
                if (it < 288) chain_item(P, it, smem);
                else s5_carry(P, (it - 288) * 256 + opaque_tid());
            }
            __syncthreads();
        }
    }
    if (multi) xcd_barrier(xb);
    if (ph_lo <= 4 && ph_hi > 4 && PH_ON(4)) {
        if (G < 304 + 32) { xcd_barrier(xb); for (int it = B; it < NSLOT * 4; it += G) mixer_s5_item(P, it, smem); }
        if (G < 304 + 32) for (int it = B; it < NSLOT * 2; it += G) mixer_dn_item(P, it);
    }
    if (multi && G < 304 + 32) xcd_barrier(xb);
    if (ph_lo <= 4 && ph_hi > 4 && PH_ON(4)) {
        for (int t = B; t < 260 * 4; t += G) {
            const int mt = t >> 2, nt = t & 3;
            EpiGluT epi{P.p + (size_t)mt * 128 * 3072, P.glu_b, nt * 128};
            gemm_tile<128>(P.p + (size_t)mt * 128 * 3072, 3072, P.Wb3 + (size_t)nt * 128 * 512, 512, 512, smem, epi);
        }
    }
    if (ph_lo <= 4 && ph_hi > 4 && PH_ON(4) && G >= 304 + 32) { for (int it = B; it < NSLOT * 2; it += G) mixer_dn_item(P, it); }
    if (multi) xcd_barrier(xb);
    if (ph_lo <= 4 && ph_hi > 4 && PH_ON(4)) {
        const int nwide2 = (260 * 4 / G) * G;
        for (int t = B; t < nwide2; t += G) {
            const int mt = t >> 2, nt = t & 3;
            const int r0 = mt * 128;
            const float* xr = r0 < NP ? P.x_prompt + (size_t)r0 * 1024 : P.x_sample + (size_t)(r0 - NP) * 1024;
            EpiOutT epi{xr, P.out + O_Y + (size_t)r0 * 1024, nt * 256};
            gemm_tile_wide(P.p + (size_t)r0 * 3072 + 512, 3072, P.Wb2 + (size_t)nt * 256 * 1024, 1024, 1024, smem, epi);
        }
        for (int u = B; u < (260 * 4 - nwide2) * 4; u += G) {
            const int t = nwide2 + (u >> 2), mt = t >> 2, nt = (t & 3) * 2 + ((u >> 1) & 1);
            const int r0 = mt * 128 + (u & 1) * 64;
            const float* xr = r0 < NP ? P.x_prompt + (size_t)r0 * 1024 : P.x_sample + (size_t)(r0 - NP) * 1024;
            EpiOutT epi{xr, P.out + O_Y + (size_t)r0 * 1024, nt * 128};
            gemm_tile<64>(P.p + (size_t)r0 * 3072 + 512, 3072, P.Wb2 + (size_t)nt * 128 * 1024, 1024, 1024, smem, epi);
        }
    }
    if (multi) xcd_barrier(xb);
    if (ph_lo <= 4 && ph_hi > 4 && PH_ON(4)) norm_rows(P, G, B);
}

extern "C" void kernel_launch(void* const* d_in, const int* in_sizes, int n_in, void* d_out, int out_size, void* d_ws, size_t ws_size, hipStream_t stream) {
    static int grid = 0;
    if (grid == 0) {
        int dev = 0, cus = 0, per_cu = 0;
        hipGetDevice(&dev);
        hipDeviceGetAttribute(&cus, hipDeviceAttributeMultiprocessorCount, dev);
        if (hipFuncSetAttribute((const void*)mega, hipFuncAttributeMaxDynamicSharedMemorySize, LDS_BYTES) != hipSuccess) fprintf(stderr, "hipFuncSetAttribute failed\n");
        if (hipOccupancyMaxActiveBlocksPerMultiprocessor(&per_cu, (const void*)mega, 256, LDS_BYTES) != hipSuccess || per_cu < 1) { fprintf(stderr, "occupancy query failed (%d)\n", per_cu); per_cu = 1; }
        (void)hipGetLastError();
        if (per_cu > 2) per_cu = 2;
        grid = cus * per_cu;
        fprintf(stderr, "mega: cus %d per_cu %d grid %d ws %zu\n", cus, per_cu, grid, ws_size);
    }
    Params p{};
    const float** pin = (const float**)&p;
    for (int i = 0; i < 24; ++i) pin[i] = (const float*)d_in[i];
    p.out = (float*)d_out;
    char* ws = (char*)d_ws; size_t off = 0;
    auto take = [&](size_t bytes) { char* r = ws + off; off += (bytes + 255) & ~(size_t)255; return r; };
    p.bar = (unsigned*)take(XCD_BAR_WORDS * 4);
    p.Wb1 = (u16*)take((size_t)3072 * 1024 * 2);
    p.Wb2 = (u16*)take((size_t)1024 * 1024 * 2);
    p.Wb3 = (u16*)take((size_t)512 * 512 * 2);
    p.bbm = (u16*)take((size_t)32 * 128 * 16 * 2);
    p.Cm = (u16*)take((size_t)32 * 16 * 128 * 2);
    p.lbt = (float*)take(2048 * 2 * 4);
    p.lb64 = (float*)take(2048 * 2 * 4);
    p.gbeta = (float*)take((size_t)T_ALL * 8 * 4);
    p.E = (float*)take((size_t)512 * 2048 * 2 * 4);
    p.carry = (float*)take((size_t)512 * 2048 * 2 * 4);
    p.p = (u16*)take((size_t)(T_ALL + 64) * 3072 * 2);
    char* shared0 = ws + off;
    p.xb = (u16*)shared0;
    p.chP = (u16*)shared0;
    p.chQ = p.chP + (size_t)NITEM * 16384;
    p.chQeff = p.chQ + (size_t)NITEM * 16384;
    p.chOl = p.chQeff + (size_t)NITEM * 8192;
    p.chS = p.chOl + (size_t)NITEM * 8192;
    const size_t need = off + (size_t)NITEM * (16384 + 16384 + 8192 + 8192 + 16384) * 2;
    if (need > ws_size) { fprintf(stderr, "workspace too small: need %zu have %zu\n", need, ws_size); return; }
    if (hipMemsetAsync(p.bar, 0, XCD_BAR_WORDS * 4, stream) != hipSuccess) fprintf(stderr, "barrier memset failed\n");
    int lo = 0, hi = 5;
    void* args[] = {&p, &lo, &hi};
    hipError_t e = hipLaunchCooperativeKernel((const void*)mega, dim3(grid), dim3(256), args, LDS_BYTES, stream);
    if (e != hipSuccess) fprintf(stderr, "cooperative launch failed: %s (grid %d)\n", hipGetErrorString(e), grid);
}
```
